# Optimizing an MI355X kernel written in HIP

```python
import math
import jax
import jax.numpy as jnp
from jax import lax
import numpy as np

D_MODEL = 1024
BATCH = 8
SEQ = 4096
DEPTH = 2

CTX_LEN = 256
GRID_W = 64
N_MOD = 6
EPS = 1e-6
NEG_INF = -1e30

HEAD_DIM = 64
ATTN_WIDTH = D_MODEL // 2
N_HEADS = ATTN_WIDTH // HEAD_DIM
N_KV_HEADS = N_HEADS // 4
KV_WIDTH = N_KV_HEADS * HEAD_DIM
WINDOW = 128
ATT_BLOCK = 128
ROPE_BASE = 10000.0

SSM_INNER = D_MODEL - ATTN_WIDTH
SSM_HEAD_DIM = 64
SSM_HEADS = SSM_INNER // SSM_HEAD_DIM
SSM_GROUPS = 2
SSM_STATE = 64
CONV_W = 5
CONV_CH = SSM_INNER + 2 * SSM_GROUPS * SSM_STATE
CHUNK = 128
N_DIRS = 2

MIX_WIDTH = ATTN_WIDTH + SSM_INNER
IN_WIDTH = ATTN_WIDTH + 2 * KV_WIDTH + SSM_INNER + CONV_CH + N_DIRS * SSM_HEADS

N_EXPERTS = 32
TOP_K = 4
D_FF = D_MODEL
SWIGLU_LIMIT = 7.0
SWIGLU_ALPHA = 1.702
MOE_BLOCK = 128

kernel_name = 'hybrid_attn_ssd_moe_diffusion_block'


def rms_norm(x, w):
    xf = x.astype(jnp.float32)
    y = xf * lax.rsqrt(jnp.mean(xf * xf, axis=-1, keepdims=True) + EPS)
    return (y * w.astype(jnp.float32)).astype(x.dtype)


def modulate(h, shift, scale):
    return h * (1.0 + scale) + shift


def axial_rope_tables(row_pos, col_pos):
    n_freq = HEAD_DIM // 4
    inv_freq = ROPE_BASE ** (-jnp.arange(n_freq, dtype=jnp.float32) / n_freq)
    ang = jnp.stack([row_pos.astype(jnp.float32)[:, None] * inv_freq,
                     col_pos.astype(jnp.float32)[:, None] * inv_freq], axis=1)
    return jnp.cos(ang)[None, :, None], jnp.sin(ang)[None, :, None]


def apply_rope(t, cos, sin):
    tr = t.astype(jnp.float32).reshape(*t.shape[:-1], 2, 2, HEAD_DIM // 4)
    t1, t2 = tr[..., 0, :], tr[..., 1, :]
    out = jnp.stack([t1 * cos - t2 * sin, t2 * cos + t1 * sin], axis=-2)
    return out.reshape(t.shape).astype(t.dtype)


def split_in_proj(p):
    b, L = p.shape[0], p.shape[1]
    s1 = ATTN_WIDTH
    s2 = s1 + KV_WIDTH
    s3 = s2 + KV_WIDTH
    s4 = s3 + SSM_INNER
    s5 = s4 + CONV_CH
    q, k, v, z, xbc, dt = jnp.split(p, [s1, s2, s3, s4, s5], axis=-1)
    return (q.reshape(b, L, N_HEADS, HEAD_DIM), k.reshape(b, L, N_KV_HEADS, HEAD_DIM),
            v.reshape(b, L, N_KV_HEADS, HEAD_DIM), z, xbc, dt.reshape(b, L, N_DIRS, SSM_HEADS))


def latent_window_attention(q, k, v, k_c, v_c, sinks):
    b, S = q.shape[0], q.shape[1]
    nb = S // ATT_BLOCK
    rep = N_HEADS // N_KV_HEADS
    scale = HEAD_DIM ** -0.5
    qb = q.reshape(b, nb, ATT_BLOCK, N_KV_HEADS, rep, HEAD_DIM)

    def band(t):
        tp = jnp.pad(t, ((0, 0), (ATT_BLOCK, ATT_BLOCK), (0, 0), (0, 0)))
        tp = tp.reshape(b, nb + 2, ATT_BLOCK, N_KV_HEADS, HEAD_DIM)
        return jnp.concatenate([tp[:, :-2], tp[:, 1:-1], tp[:, 2:]], axis=2)

    kb, vb = band(k), band(v)
    s_win = jnp.einsum('bnqgrd,bnkgd->bngrqk', qb, kb).astype(jnp.float32) * scale
    qpos = jnp.arange(nb)[:, None] * ATT_BLOCK + jnp.arange(ATT_BLOCK)[None, :]
    kpos = jnp.arange(nb)[:, None] * ATT_BLOCK - ATT_BLOCK + jnp.arange(3 * ATT_BLOCK)[None, :]
    valid = ((jnp.abs(qpos[:, :, None] - kpos[:, None, :]) <= WINDOW)
             & (kpos[:, None, :] >= 0) & (kpos[:, None, :] < S))
    s_win = jnp.where(valid[None, :, None, None], s_win, NEG_INF)
    s_ctx = jnp.einsum('bnqgrd,bcgd->bngrqc', qb, k_c).astype(jnp.float32) * scale
    s_sink = jnp.broadcast_to(sinks.astype(jnp.float32).reshape(N_KV_HEADS, rep, 1, 1),
                              s_ctx.shape[:-1] + (1,))
    probs = jax.nn.softmax(jnp.concatenate([s_ctx, s_win, s_sink], axis=-1), axis=-1).astype(v.dtype)
    n_ctx = k_c.shape[1]
    out = (jnp.einsum('bngrqc,bcgd->bnqgrd', probs[..., :n_ctx], v_c)
           + jnp.einsum('bngrqk,bnkgd->bnqgrd', probs[..., n_ctx:n_ctx + 3 * ATT_BLOCK], vb))
    return out.reshape(b, S, ATTN_WIDTH)


def context_attention(q_c, k_c, v_c, sinks):
    b, n_ctx = q_c.shape[0], q_c.shape[1]
    rep = N_HEADS // N_KV_HEADS
    qcb = q_c.reshape(b, n_ctx, N_KV_HEADS, rep, HEAD_DIM)
    s = jnp.einsum('bqgrd,bkgd->bgrqk', qcb, k_c).astype(jnp.float32) * HEAD_DIM ** -0.5
    s_sink = jnp.broadcast_to(sinks.astype(jnp.float32).reshape(N_KV_HEADS, rep, 1, 1), s.shape[:-1] + (1,))
    probs = jax.nn.softmax(jnp.concatenate([s, s_sink], axis=-1), axis=-1).astype(v_c.dtype)
    out = jnp.einsum('bgrqk,bkgd->bqgrd', probs[..., :n_ctx], v_c)
    return out.reshape(b, n_ctx, ATTN_WIDTH)


def centred_dwconv(u, w, bias):
    out = lax.conv_general_dilated(
        u, w[:, None, :].astype(u.dtype), window_strides=(1,),
        padding=[(CONV_W // 2, CONV_W // 2)], dimension_numbers=('NWC', 'WIO', 'NWC'),
        feature_group_count=u.shape[-1])
    return out + bias.astype(u.dtype)


def conv_split(xbc, conv_w, conv_b):
    u = jax.nn.silu(centred_dwconv(xbc, conv_w, conv_b)).astype(jnp.float32)
    b, L = u.shape[0], u.shape[1]
    gs = SSM_GROUPS * SSM_STATE
    xs = u[..., :SSM_INNER].reshape(b, L, SSM_HEADS, SSM_HEAD_DIM)
    bm = u[..., SSM_INNER:SSM_INNER + gs].reshape(b, L, SSM_GROUPS, SSM_STATE)
    cm = u[..., SSM_INNER + gs:].reshape(b, L, SSM_GROUPS, SSM_STATE)
    return xs, bm, cm


def ssd_chunked(x, dt, a, bm, cm, h0):
    b, L, H, P = x.shape
    nc = L // CHUNK
    rep = H // SSM_GROUPS
    xc = x.reshape(b, nc, CHUNK, H, P)
    dtc = dt.reshape(b, nc, CHUNK, H)
    bh = jnp.repeat(bm, rep, axis=2).reshape(b, nc, CHUNK, H, SSM_STATE)
    ch = jnp.repeat(cm, rep, axis=2).reshape(b, nc, CHUNK, H, SSM_STATE)
    cs = jnp.cumsum(dtc * a, axis=2)
    lower = jnp.tril(jnp.ones((CHUNK, CHUNK), dtype=bool))[None, None, :, :, None]
    seg = cs[:, :, :, None, :] - cs[:, :, None, :, :]
    decay = jnp.where(lower, jnp.exp(jnp.where(lower, seg, 0.0)), 0.0)
    scores = jnp.einsum('bcihn,bcjhn->bcijh', ch, bh) * decay * dtc[:, :, None, :, :]
    y_diag = jnp.einsum('bcijh,bcjhp->bcihp', scores, xc)
    to_end = jnp.exp(cs[:, :, -1:, :] - cs) * dtc
    states = jnp.einsum('bcjhn,bcjh,bcjhp->bchpn', bh, to_end, xc)
    chunk_decay = jnp.exp(cs[:, :, -1, :])

    def step(h, inp):
        s, dcy = inp
        return dcy[:, :, None, None] * h + s, h

    h_final, h_prev = lax.scan(step, h0, (jnp.moveaxis(states, 1, 0), jnp.moveaxis(chunk_decay, 1, 0)))
    h_prev = jnp.moveaxis(h_prev, 0, 1)
    y_off = jnp.einsum('bcihn,bchpn,bcih->bcihp', ch, h_prev, jnp.exp(cs))
    return (y_diag + y_off).reshape(b, L, H, P), h_final


def gated_rms_norm(y, z, w):
    b, L = y.shape[0], y.shape[1]
    g = y.reshape(b, L, SSM_INNER) * jax.nn.silu(z.astype(jnp.float32))
    g = g.reshape(b, L, SSM_GROUPS, SSM_INNER // SSM_GROUPS)
    g = g * lax.rsqrt(jnp.mean(g * g, axis=-1, keepdims=True) + EPS)
    return (g.reshape(b, L, SSM_INNER) * w.astype(jnp.float32)).astype(z.dtype)


def bidirectional_ssd(xbc, xbc_c, z, z_c, dt_raw, dt_raw_c, conv_w, conv_b, dt_bias, a_log, d_skip, norm_w):
    xs, bm, cm = conv_split(xbc, conv_w, conv_b)
    xs_c, bm_c, cm_c = conv_split(xbc_c, conv_w, conv_b)
    skip = d_skip.astype(jnp.float32)[:, None]
    y = skip * xs
    y_c = skip * xs_c
    h0 = jnp.zeros((xs.shape[0], SSM_HEADS, SSM_HEAD_DIM, SSM_STATE), jnp.float32)
    for d in range(N_DIRS):
        if d == 0:
            orient = lambda t: t
        else:
            orient = lambda t: jnp.flip(t, axis=1)
        a = -jnp.exp(a_log[d].astype(jnp.float32))
        dt = jax.nn.softplus(dt_raw[:, :, d].astype(jnp.float32) + dt_bias[d].astype(jnp.float32))
        dt_c = jax.nn.softplus(dt_raw_c[:, :, d].astype(jnp.float32) + dt_bias[d].astype(jnp.float32))
        yc_d, h_ctx = ssd_chunked(orient(xs_c), orient(dt_c), a, orient(bm_c), orient(cm_c), h0)
        y_d, _ = ssd_chunked(orient(xs), orient(dt), a, orient(bm), orient(cm), h_ctx)
        y = y + orient(y_d)
        y_c = y_c + orient(yc_d)
    return gated_rms_norm(y, z, norm_w), gated_rms_norm(y_c, z_c, norm_w)


def hybrid_mixer(h, hc, cos, sin, w_in, conv_w, conv_b, dt_bias, a_log, d_skip,
                 ssm_norm_w, attn_sinks, attn_norm_w, w_out, with_ctx_out):
    q, k, v, z, xbc, dt_raw = split_in_proj(h @ w_in)
    q_c, k_c, v_c, z_c, xbc_c, dt_raw_c = split_in_proj(hc @ w_in)
    q = apply_rope(q, cos, sin)
    k = apply_rope(k, cos, sin)
    attn = rms_norm(latent_window_attention(q, k, v, k_c, v_c, attn_sinks), attn_norm_w)
    ssm, ssm_c = bidirectional_ssd(xbc, xbc_c, z, z_c, dt_raw, dt_raw_c, conv_w, conv_b,
                                   dt_bias, a_log, d_skip, ssm_norm_w)
    out = jnp.concatenate([attn, ssm], axis=-1) @ w_out
    if not with_ctx_out:
        return out, None
    attn_c = rms_norm(context_attention(q_c, k_c, v_c, attn_sinks), attn_norm_w)
    out_c = jnp.concatenate([attn_c, ssm_c], axis=-1) @ w_out
    return out, out_c


def clamped_swiglu(gu):
    glu, lin = jnp.split(gu, 2, axis=-1)
    glu = jnp.minimum(glu, SWIGLU_LIMIT)
    lin = jnp.clip(lin, -SWIGLU_LIMIT, SWIGLU_LIMIT)
    return glu * jax.nn.sigmoid(SWIGLU_ALPHA * glu) * (lin + 1.0)


def moe_ffn(h, w_router, b_router, w_gate_up, b_gate_up, w_down, b_down):
    n, d = h.shape
    nk = n * TOP_K
    logits = (h @ w_router + b_router).astype(jnp.float32)
    top_logit, top_idx = lax.top_k(logits, TOP_K)
    gates = jax.nn.softmax(top_logit, axis=-1).astype(h.dtype)
    flat_e = top_idx.reshape(nk).astype(jnp.int32)
    flat_tok = jnp.arange(nk, dtype=jnp.int32) // TOP_K
    order = jnp.argsort(flat_e)
    s_e, s_tok, s_gate = flat_e[order], flat_tok[order], gates.reshape(nk)[order]
    counts = jnp.bincount(flat_e, length=N_EXPERTS).astype(jnp.int32)
    start = jnp.cumsum(counts) - counts
    padded = (counts + MOE_BLOCK - 1) // MOE_BLOCK * MOE_BLOCK
    pad_end = jnp.cumsum(padded)
    pad_start = pad_end - padded
    dest = pad_start[s_e] + jnp.arange(nk, dtype=jnp.int32) - start[s_e]
    n_blocks = -(-nk // MOE_BLOCK) + N_EXPERTS
    buf = jnp.zeros((n_blocks * MOE_BLOCK, d), h.dtype).at[dest].set(h[s_tok])
    block_e = jnp.minimum(
        jnp.searchsorted(pad_end, jnp.arange(n_blocks, dtype=jnp.int32) * MOE_BLOCK, side='right'),
        N_EXPERTS - 1)

    def expert_block(args):
        xb, e = args
        return clamped_swiglu(xb @ w_gate_up[e] + b_gate_up[e]) @ w_down[e] + b_down[e]

    out_buf = lax.map(expert_block, (buf.reshape(n_blocks, MOE_BLOCK, d), block_e))
    contrib = out_buf.reshape(n_blocks * MOE_BLOCK, d)[dest] * s_gate[:, None]
    return jax.ops.segment_sum(contrib, s_tok, num_segments=n)


def setup_inputs(seed: int = 0) -> dict:
    key = jax.random.key(seed)
    ks = jax.random.split(key, 26)

    def nrm(k, shape, s):
        return jax.random.normal(k, shape, jnp.float32) * s

    dt0 = jnp.exp(jax.random.uniform(ks[11], (DEPTH, N_DIRS, SSM_HEADS), jnp.float32,
                                     math.log(1e-3), math.log(1e-1)))
    return {
        'x': nrm(ks[0], (BATCH, SEQ, D_MODEL), 1.0),
        'c': nrm(ks[1], (BATCH, D_MODEL), 1.0),
        'ctx': nrm(ks[2], (BATCH, CTX_LEN, D_MODEL), 1.0),
        'c_ctx': nrm(ks[3], (D_MODEL,), 1.0),
        'w_ada': nrm(ks[4], (DEPTH, D_MODEL, N_MOD * D_MODEL), 0.5 * D_MODEL ** -0.5),
        'b_ada': nrm(ks[5], (DEPTH, N_MOD * D_MODEL), 0.02),
        'norm_mix_w': 1.0 + nrm(ks[6], (DEPTH, D_MODEL), 0.1),
        'norm_ffn_w': 1.0 + nrm(ks[7], (DEPTH, D_MODEL), 0.1),
        'w_in': nrm(ks[8], (DEPTH, D_MODEL, IN_WIDTH), D_MODEL ** -0.5),
        'conv_w': nrm(ks[9], (DEPTH, CONV_W, CONV_CH), CONV_W ** -0.5),
        'conv_b': nrm(ks[10], (DEPTH, CONV_CH), 0.02),
        'dt_bias': dt0 + jnp.log(-jnp.expm1(-dt0)),
        'a_log': jnp.log(jax.random.uniform(ks[12], (DEPTH, N_DIRS, SSM_HEADS), jnp.float32, 1.0, 16.0)),
        'd_skip': 1.0 + nrm(ks[13], (DEPTH, SSM_HEADS), 0.1),
        'ssm_norm_w': 1.0 + nrm(ks[14], (DEPTH, SSM_INNER), 0.1),
        'attn_sinks': nrm(ks[15], (DEPTH, N_HEADS), 0.5),
        'attn_norm_w': 1.0 + nrm(ks[16], (DEPTH, ATTN_WIDTH), 0.1),
        'w_out': nrm(ks[17], (DEPTH, MIX_WIDTH, D_MODEL), MIX_WIDTH ** -0.5),
        'w_router': nrm(ks[18], (DEPTH, D_MODEL, N_EXPERTS), D_MODEL ** -0.5),
        'b_router': nrm(ks[19], (DEPTH, N_EXPERTS), 0.01),
        'w_gate_up': nrm(ks[20], (DEPTH, N_EXPERTS, D_MODEL, 2 * D_FF), D_MODEL ** -0.5),
        'b_gate_up': nrm(ks[21], (DEPTH, N_EXPERTS, 2 * D_FF), 0.01),
        'w_down': nrm(ks[22], (DEPTH, N_EXPERTS, D_FF, D_MODEL), D_FF ** -0.5),
        'b_down': nrm(ks[23], (DEPTH, N_EXPERTS, D_MODEL), 0.01),
        'final_norm_w': 1.0 + nrm(ks[24], (D_MODEL,), 0.1),
    }


def reference(x, c, ctx, c_ctx, w_ada, b_ada, norm_mix_w, norm_ffn_w, w_in, conv_w, conv_b,
              dt_bias, a_log, d_skip, ssm_norm_w, attn_sinks, attn_norm_w, w_out,
              w_router, b_router, w_gate_up, b_gate_up, w_down, b_down, final_norm_w):
    b, S, D = x.shape
    n_ctx = ctx.shape[1]
    rows = S // GRID_W
    row_pos = jnp.repeat(jnp.arange(rows, dtype=jnp.int32), GRID_W)
    col_pos = jnp.tile(jnp.arange(GRID_W, dtype=jnp.int32), rows)
    cos, sin = axial_rope_tables(row_pos, col_pos)
    xc = ctx
    for l in range(DEPTH):
        last = l == DEPTH - 1
        mod = jax.nn.silu(c) @ w_ada[l] + b_ada[l]
        mod_c = jax.nn.silu(c_ctx) @ w_ada[l] + b_ada[l]
        sh1, sc1, g1, sh2, sc2, g2 = jnp.split(mod[:, None, :], N_MOD, axis=-1)
        sh1c, sc1c, g1c, sh2c, sc2c, g2c = jnp.split(mod_c, N_MOD, axis=-1)
        h = modulate(rms_norm(x, norm_mix_w[l]), sh1, sc1)
        hc = modulate(rms_norm(xc, norm_mix_w[l]), sh1c, sc1c)
        mix, mix_c = hybrid_mixer(h, hc, cos, sin, w_in[l], conv_w[l], conv_b[l], dt_bias[l], a_log[l],
                                  d_skip[l], ssm_norm_w[l], attn_sinks[l], attn_norm_w[l], w_out[l],
                                  not last)
        x = x + g1 * mix
        if not last:
            xc = xc + g1c * mix_c
            h2 = modulate(rms_norm(x, norm_ffn_w[l]), sh2, sc2)
            h2c = modulate(rms_norm(xc, norm_ffn_w[l]), sh2c, sc2c)
            tokens = jnp.concatenate([h2.reshape(b * S, D), h2c.reshape(b * n_ctx, D)], axis=0)
            f = moe_ffn(tokens, w_router[l], b_router[l], w_gate_up[l], b_gate_up[l], w_down[l], b_down[l])
            x = x + g2 * f[:b * S].reshape(b, S, D)
            xc = xc + g2c * f[b * S:].reshape(b, n_ctx, D)
        else:
            h2 = modulate(rms_norm(x, norm_ffn_w[l]), sh2, sc2)
            f = moe_ffn(h2.reshape(b * S, D), w_router[l], b_router[l], w_gate_up[l], b_gate_up[l],
                        w_down[l], b_down[l])
            x = x + g2 * f.reshape(b, S, D)
    return rms_norm(x, final_norm_w)
```

```cpp
#include <hip/hip_runtime.h>
#include <hip/hip_cooperative_groups.h>
#include <cstdio>
#include <cstdint>
#include <cstddef>
namespace cg = cooperative_groups;

typedef unsigned short bf16_t;
typedef short bf16x8 __attribute__((ext_vector_type(8)));
typedef float f32x4 __attribute__((ext_vector_type(4)));
typedef unsigned u32x4 __attribute__((ext_vector_type(4)));

#ifndef N_LAUNCH_MODE
#define N_LAUNCH_MODE 0
#endif

constexpr int D = 1024, NBATCH = 8, S = 4096, CTX = 256;
constexpr int NL = NBATCH * S, NC = NBATCH * CTX, NT = NL + NC;
constexpr int NIN = 2176, NINV = 2064;
constexpr int OQ = 0, OKK = 512, OV = 640, OZ = 768, OXBC = 1280, ODT = 2048;
constexpr int NE = 32;
constexpr int ACT_ROWS = NT * 4 + NE * 128;
constexpr float EPS = 1e-6f;
constexpr int NTHR = 256;
constexpr int LDS_BYTES = 72 * 1024;

constexpr size_t al256(size_t x) { return (x + 255) & ~(size_t)255; }
constexpr size_t WS_CTL   = 0;
constexpr size_t WS_CNT   = 65536;
constexpr size_t WS_ROPE  = WS_CNT + 4096;
constexpr size_t WS_MOD   = WS_ROPE + 8192;
constexpr size_t WS_WIN   = al256(WS_MOD + (size_t)2 * 9 * 6144 * 4);
constexpr size_t WS_WOUT  = al256(WS_WIN + (size_t)2 * NIN * 1024 * 2);
constexpr size_t WS_WGU   = al256(WS_WOUT + (size_t)2 * 1024 * 1024 * 2);
constexpr size_t WS_WDN   = al256(WS_WGU + (size_t)64 * 2048 * 1024 * 2);
constexpr size_t WS_H     = al256(WS_WDN + (size_t)64 * 1024 * 1024 * 2);
constexpr size_t WS_P     = al256(WS_H + (size_t)NT * 1024 * 2);
constexpr size_t WS_U     = al256(WS_P + (size_t)NT * NIN * 4);
constexpr size_t WS_ATT   = al256(WS_U + (size_t)NT * 768 * 4);
constexpr size_t WS_YS    = al256(WS_ATT + (size_t)NT * 512 * 4);
constexpr size_t WS_MIX   = al256(WS_YS + (size_t)2 * NT * 512 * 4);
constexpr size_t WS_XW    = al256(WS_MIX + (size_t)NT * 1024 * 2);
constexpr size_t WS_LIST  = al256(WS_XW + (size_t)NT * 1024 * 4);
constexpr size_t WS_ROUTE = al256(WS_LIST + (size_t)NE * NT * 4);
constexpr size_t WS_GATE  = al256(WS_ROUTE + (size_t)NT * 4 * 4);
constexpr size_t WS_ACT   = al256(WS_GATE + (size_t)NT * 4 * 4);
constexpr size_t WS_Y     = al256(WS_ACT + (size_t)ACT_ROWS * 1024 * 2);
constexpr size_t WS_END   = al256(WS_Y + (size_t)ACT_ROWS * 1024 * 2);

struct Params {
    const float* in[25];
    float* out;
    unsigned char* ws;
    int ph_lo, ph_hi;
};
enum { I_X = 0, I_C, I_CTX, I_CCTX, I_WADA, I_BADA, I_NMIX, I_NFFN, I_WIN, I_CONVW, I_CONVB, I_DTB, I_ALOG, I_DSKIP, I_SSMNW, I_SINK,
       I_ATTNW, I_WOUT, I_WR, I_BR, I_WGU, I_BGU, I_WDN, I_BDN, I_FNW };

__device__ __forceinline__ unsigned short f2bf(float f) {
    unsigned u = __float_as_uint(f);
    u += 0x7fffu + ((u >> 16) & 1u);
    return (unsigned short)(u >> 16);
}
__device__ __forceinline__ unsigned pack2bf(float lo, float hi) { return (unsigned)f2bf(lo) | ((unsigned)f2bf(hi) << 16); }
__device__ __forceinline__ float bf2f(unsigned short h) { return __uint_as_float((unsigned)h << 16); }
__device__ __forceinline__ float silu_f(float x) { return x / (1.f + __expf(-x)); }
__device__ __forceinline__ float wave_sum(float v) {
#pragma unroll
    for (int o = 32; o >= 1; o >>= 1) v += __shfl_xor(v, o);
    return v;
}
__device__ __forceinline__ int mod_row(int row) { return row < NL ? (row >> 12) : 8; }

template <int NB, class RowPtr, class Epi>
__device__ __forceinline__ void gemm_tile(unsigned char* lds, RowPtr rowptr, const bf16_t* Bg0, const bf16_t* Bg1, Epi epi) {
    const int tid = threadIdx.x, wid = tid >> 6, lane = tid & 63, wr = wid >> 1, wc = wid & 1, fr = lane & 15, fq = lane >> 4;
    unsigned char* As = lds;
    unsigned char* Bs = lds + 8192;
    const bf16_t* pa[2];
    const bf16_t* pb[NB][2];
    int ldsoff[2];
#pragma unroll
    for (int i = 0; i < 2; ++i) {
        const int c = tid + i * 256, row = c >> 2, kc = c & 3;
        pa[i] = rowptr(row) + kc * 8;
        pb[0][i] = Bg0 + (size_t)row * 1024 + kc * 8;
        if (NB == 2) pb[NB - 1][i] = Bg1 + (size_t)row * 1024 + kc * 8;
        ldsoff[i] = row * 64 + kc * 16;
    }
    f32x4 acc[NB][4][4];
#pragma unroll
    for (int nb = 0; nb < NB; ++nb)
#pragma unroll
        for (int m = 0; m < 4; ++m)
#pragma unroll
            for (int n = 0; n < 4; ++n) acc[nb][m][n] = (f32x4){0.f, 0.f, 0.f, 0.f};
    u32x4 ra[2], rb[NB][2];
#pragma unroll
    for (int i = 0; i < 2; ++i) {
        ra[i] = *(const u32x4*)(pa[i]);
#pragma unroll
        for (int nb = 0; nb < NB; ++nb) rb[nb][i] = *(const u32x4*)(pb[nb][i]);
    }
    for (int kt = 0; kt < 32; ++kt) {
        __syncthreads();
#pragma unroll
        for (int i = 0; i < 2; ++i) {
            *(u32x4*)(As + ldsoff[i]) = ra[i];
#pragma unroll
            for (int nb = 0; nb < NB; ++nb) *(u32x4*)(Bs + nb * 8192 + ldsoff[i]) = rb[nb][i];
        }
        __syncthreads();
        if (kt + 1 < 32) {
            const int k0 = (kt + 1) * 32;
#pragma unroll
            for (int i = 0; i < 2; ++i) {
                ra[i] = *(const u32x4*)(pa[i] + k0);
#pragma unroll
                for (int nb = 0; nb < NB; ++nb) rb[nb][i] = *(const u32x4*)(pb[nb][i] + k0);
            }
        }
        bf16x8 af[4];
#pragma unroll
        for (int m = 0; m < 4; ++m) af[m] = *(const bf16x8*)(As + (wr * 64 + m * 16 + fr) * 64 + fq * 16);
#pragma unroll
        for (int nb = 0; nb < NB; ++nb) {
            bf16x8 bfr[4];
#pragma unroll
            for (int n = 0; n < 4; ++n) bfr[n] = *(const bf16x8*)(Bs + nb * 8192 + (wc * 64 + n * 16 + fr) * 64 + fq * 16);
#pragma unroll
            for (int m = 0; m < 4; ++m)
#pragma unroll
                for (int n = 0; n < 4; ++n) acc[nb][m][n] = __builtin_amdgcn_mfma_f32_16x16x32_bf16(af[m], bfr[n], acc[nb][m][n], 0, 0, 0);
        }
    }
#pragma unroll
    for (int m = 0; m < 4; ++m) {
#pragma unroll
        for (int n = 0; n < 4; ++n)
#pragma unroll
            for (int j = 0; j < 4; ++j) {
                const int r = wr * 64 + m * 16 + fq * 4 + j, c = wc * 64 + n * 16 + fr;
                epi(r, c, acc[0][m][n][j], acc[NB - 1][m][n][j]);
            }
        __builtin_amdgcn_sched_barrier(0);
    }
    __syncthreads();
}


struct RowDense { const bf16_t* base; __device__ __forceinline__ const bf16_t* operator()(int r) const { return base + (size_t)r * 1024; } };
struct RowGather { const bf16_t* H; const int* lst; int m0, cm1;
    __device__ __forceinline__ const bf16_t* operator()(int r) const { int i = m0 + r; i = i > cm1 ? cm1 : i; return H + (size_t)lst[i] * 1024; } };
struct EpiStoreF32 { float* C; int ld; __device__ __forceinline__ void operator()(int r, int c, float v0, float) const { C[(size_t)r * ld + c] = v0; } };
struct EpiResid { float* X; const float* g1; __device__ __forceinline__ void operator()(int r, int c, float v0, float) const { X[(size_t)r * 1024 + c] += g1[c] * v0; } };
struct EpiSwiglu { bf16_t* A; const float* bg;
    __device__ __forceinline__ void operator()(int r, int c, float v0, float v1) const {
        float glu = v0 + bg[c], lin = v1 + bg[1024 + c];
        glu = fminf(glu, 7.f); lin = fminf(fmaxf(lin, -7.f), 7.f);
        const float a = glu / (1.f + __expf(-1.702f * glu)) * (lin + 1.f);
        A[(size_t)r * 1024 + c] = f2bf(a);
    } };
struct EpiBiasBf16 { bf16_t* Y; const float* bd; __device__ __forceinline__ void operator()(int r, int c, float v0, float) const { Y[(size_t)r * 1024 + c] = f2bf(v0 + bd[c]); } };

__device__ __forceinline__ void transpose_tile(unsigned char* lds, const float* src, int ldn, int nvalid, bf16_t* dst, int k0, int n0) {
    float* T = (float*)lds;
    const int tid = threadIdx.x;
#pragma unroll
    for (int i = 0; i < 4; ++i) {
        const int r = (tid >> 4) + 16 * i, c4 = (tid & 15) * 4, n = n0 + c4;
        float4 v = make_float4(0.f, 0.f, 0.f, 0.f);
        if (n < nvalid) v = *(const float4*)(src + (size_t)(k0 + r) * ldn + n);
        T[r * 65 + c4 + 0] = v.x; T[r * 65 + c4 + 1] = v.y; T[r * 65 + c4 + 2] = v.z; T[r * 65 + c4 + 3] = v.w;
    }
    __syncthreads();
#pragma unroll
    for (int i = 0; i < 2; ++i) {
        const int n = (tid >> 3) + 32 * i, kc = tid & 7;
        float v[8];
#pragma unroll
        for (int j = 0; j < 8; ++j) v[j] = T[(kc * 8 + j) * 65 + n];
        uint4 w; w.x = pack2bf(v[0], v[1]); w.y = pack2bf(v[2], v[3]); w.z = pack2bf(v[4], v[5]); w.w = pack2bf(v[6], v[7]);
        *(uint4*)(dst + (size_t)(n0 + n) * 1024 + k0 + kc * 8) = w;
    }
    __syncthreads();
}

__device__ __forceinline__ void ph_setup(const Params& p, unsigned char* lds) {
    const int tid = threadIdx.x, G = gridDim.x, bid = blockIdx.x;
    if (bid == 0) {
        int* cnt = (int*)(p.ws + WS_CNT);
        if (tid < 64) cnt[tid] = 0;
        float* rc = (float*)(p.ws + WS_ROPE);
        for (int i = tid; i < 1024; i += NTHR) {
            const int pos = i >> 4, f = i & 15;
            double th = 1.0;
            for (int q = 0; q < f; ++q) th *= 0.56234132519034908;
            const double t2 = th * th;
            double c1 = 1.0, s1 = th, tc = 1.0, tsn = th;
            for (int q = 1; q <= 12; ++q) {
                tc *= -t2 / (double)((2 * q - 1) * (2 * q));
                tsn *= -t2 / (double)((2 * q) * (2 * q + 1));
                c1 += tc; s1 += tsn;
            }
            double cc = 1.0, ss = 0.0;
            for (int q = 0; q < pos; ++q) { const double nc = cc * c1 - ss * s1, ns = ss * c1 + cc * s1; cc = nc; ss = ns; }
            rc[i] = (float)cc; rc[1024 + i] = (float)ss;
        }
    }
    {
        float* sil = (float*)lds;
        float* part = sil + 9 * 1024;
        float* MOD = (float*)(p.ws + WS_MOD);
        const int wid = tid >> 6, lane = tid & 63;
        for (int it = bid; it < 192; it += G) {
            const int l = it / 96, j0 = (it % 96) * 64;
            for (int idx = tid; idx < 9 * 1024; idx += NTHR) {
                const int r = idx >> 10, k = idx & 1023;
                const float v = r < 8 ? p.in[I_C][r * 1024 + k] : p.in[I_CCTX][k];
                sil[idx] = silu_f(v);
            }
            __syncthreads();
            float acc[9];
#pragma unroll
            for (int r = 0; r < 9; ++r) acc[r] = 0.f;
            const float* w = p.in[I_WADA] + (size_t)l * 1024 * 6144 + j0 + lane;
            for (int k = wid * 256; k < wid * 256 + 256; ++k) {
                const float wv = w[(size_t)k * 6144];
#pragma unroll
                for (int r = 0; r < 9; ++r) acc[r] += sil[r * 1024 + k] * wv;
            }
#pragma unroll
            for (int r = 0; r < 9; ++r) part[(wid * 9 + r) * 64 + lane] = acc[r];
            __syncthreads();
            for (int idx = tid; idx < 9 * 64; idx += NTHR) {
                const int r = idx >> 6, c = idx & 63;
                const float s = part[(0 * 9 + r) * 64 + c] + part[(1 * 9 + r) * 64 + c] + part[(2 * 9 + r) * 64 + c] + part[(3 * 9 + r) * 64 + c];
                MOD[(size_t)(l * 9 + r) * 6144 + j0 + c] = s + p.in[I_BADA][l * 6144 + j0 + c];
            }
            __syncthreads();
        }
    }
    {
        constexpr int T0 = 2 * 16 * 34, T1 = 2 * 16 * 16, T2 = 64 * 16 * 32, T3 = 64 * 16 * 16;
        for (int it = bid; it < T0 + T1 + T2 + T3; it += G) {
            if (it < T0) {
                const int l = it / (16 * 34), r = it % (16 * 34), kt = r / 34, nt = r % 34;
                transpose_tile(lds, p.in[I_WIN] + (size_t)l * 1024 * NINV, NINV, NINV, (bf16_t*)(p.ws + WS_WIN) + (size_t)l * NIN * 1024, kt * 64, nt * 64);
            } else if (it < T0 + T1) {
                const int i2 = it - T0, l = i2 / 256, r = i2 % 256, kt = r / 16, nt = r % 16;
                transpose_tile(lds, p.in[I_WOUT] + (size_t)l * 1024 * 1024, 1024, 1024, (bf16_t*)(p.ws + WS_WOUT) + (size_t)l * 1024 * 1024, kt * 64, nt * 64);
            } else if (it < T0 + T1 + T2) {
                const int i2 = it - T0 - T1, le = i2 / 512, r = i2 % 512, kt = r / 32, nt = r % 32;
                transpose_tile(lds, p.in[I_WGU] + (size_t)le * 1024 * 2048, 2048, 2048, (bf16_t*)(p.ws + WS_WGU) + (size_t)le * 2048 * 1024, kt * 64, nt * 64);
            } else {
                const int i2 = it - T0 - T1 - T2, le = i2 / 256, r = i2 % 256, kt = r / 16, nt = r % 16;
                transpose_tile(lds, p.in[I_WDN] + (size_t)le * 1024 * 1024, 1024, 1024, (bf16_t*)(p.ws + WS_WDN) + (size_t)le * 1024 * 1024, kt * 64, nt * 64);
            }
        }
    }
}

__device__ __forceinline__ int expert_rowbase(const int* cnt, int e) {
    int base = 0;
    for (int q = 0; q < e; ++q) base += ((cnt[q] + 127) >> 7) << 7;
    return base;
}

__device__ __forceinline__ void ph_prep1(const Params& p, int l) {
    const int tid = threadIdx.x, lane = tid & 63, gw = blockIdx.x * 4 + (tid >> 6), GW = gridDim.x * 4;
    float* XW = (float*)(p.ws + WS_XW);
    bf16_t* H = (bf16_t*)(p.ws + WS_H);
    const float* MOD = (const float*)(p.ws + WS_MOD);
    const float* nw = p.in[I_NMIX] + l * 1024;
    int mybase = 0;
    if (l == 1) mybase = expert_rowbase((const int*)(p.ws + WS_CNT), lane & 31);
    for (int row = gw; row < NT; row += GW) {
        const int mr = mod_row(row);
        float4 xv[4];
        if (l == 0) {
            const float* src = row < NL ? p.in[I_X] + (size_t)row * 1024 : p.in[I_CTX] + (size_t)(row - NL) * 1024;
#pragma unroll
            for (int j = 0; j < 4; ++j) xv[j] = *(const float4*)(src + j * 256 + lane * 4);
        } else {
#pragma unroll
            for (int j = 0; j < 4; ++j) xv[j] = *(const float4*)(XW + (size_t)row * 1024 + j * 256 + lane * 4);
            const int* route = (const int*)(p.ws + WS_ROUTE) + row * 4;
            const float* gate = (const float*)(p.ws + WS_GATE) + row * 4;
            const bf16_t* Y = (const bf16_t*)(p.ws + WS_Y);
            const float* g2 = MOD + (size_t)(0 * 9 + mr) * 6144 + 5120;
            float4 fs[4];
#pragma unroll
            for (int j = 0; j < 4; ++j) fs[j] = make_float4(0.f, 0.f, 0.f, 0.f);
#pragma unroll
            for (int k = 0; k < 4; ++k) {
                const int rt = route[k]; const float gk = gate[k];
                const int e = rt >> 16, slot = rt & 0xffff;
                const int pos = __shfl(mybase, e) + slot;
                const bf16_t* yr = Y + (size_t)pos * 1024;
#pragma unroll
                for (int j = 0; j < 4; ++j) {
                    const uint2 w = *(const uint2*)(yr + j * 256 + lane * 4);
                    fs[j].x += gk * bf2f((unsigned short)(w.x & 0xffff)); fs[j].y += gk * bf2f((unsigned short)(w.x >> 16));
                    fs[j].z += gk * bf2f((unsigned short)(w.y & 0xffff)); fs[j].w += gk * bf2f((unsigned short)(w.y >> 16));
                }
            }
#pragma unroll
            for (int j = 0; j < 4; ++j) {
                const float4 g = *(const float4*)(g2 + j * 256 + lane * 4);
                xv[j].x += g.x * fs[j].x; xv[j].y += g.y * fs[j].y; xv[j].z += g.z * fs[j].z; xv[j].w += g.w * fs[j].w;
            }
        }
#pragma unroll
        for (int j = 0; j < 4; ++j) *(float4*)(XW + (size_t)row * 1024 + j * 256 + lane * 4) = xv[j];
        float ss = 0.f;
#pragma unroll
        for (int j = 0; j < 4; ++j) ss += xv[j].x * xv[j].x + xv[j].y * xv[j].y + xv[j].z * xv[j].z + xv[j].w * xv[j].w;
        ss = wave_sum(ss);
        const float rstd = rsqrtf(ss * (1.f / 1024.f) + EPS);
        const float* sh = MOD + (size_t)(l * 9 + mr) * 6144;
        const float* sc = sh + 1024;
#pragma unroll
        for (int j = 0; j < 4; ++j) {
            const int k = j * 256 + lane * 4;
            const float4 w = *(const float4*)(nw + k), a = *(const float4*)(sc + k), b = *(const float4*)(sh + k);
            const float h0 = xv[j].x * rstd * w.x * (1.f + a.x) + b.x, h1 = xv[j].y * rstd * w.y * (1.f + a.y) + b.y;
            const float h2 = xv[j].z * rstd * w.z * (1.f + a.z) + b.z, h3 = xv[j].w * rstd * w.w * (1.f + a.w) + b.w;
            uint2 o; o.x = pack2bf(h0, h1); o.y = pack2bf(h2, h3);
            *(uint2*)(H + (size_t)row * 1024 + k) = o;
        }
    }
}

__device__ __forceinline__ void ph_inproj(const Params& p, int l, unsigned char* lds) {
    const bf16_t* H = (const bf16_t*)(p.ws + WS_H);
    const bf16_t* W = (const bf16_t*)(p.ws + WS_WIN) + (size_t)l * NIN * 1024;
    float* P = (float*)(p.ws + WS_P);
    constexpr int NTN = NIN / 128, NTM = NT / 128;
    for (int it = blockIdx.x; it < NTM * NTN; it += gridDim.x) {
        const int mt = it / NTN, nt = it % NTN;
        const bf16_t* A0 = H + (size_t)mt * 128 * 1024;
        float* P0 = P + (size_t)mt * 128 * NIN + nt * 128;
        gemm_tile<1>(lds, RowDense{A0}, W + (size_t)nt * 128 * 1024, nullptr, EpiStoreF32{P0, NIN});
    }
}

__device__ __forceinline__ void attn_item(const Params& p, int l, unsigned char* lds, int b, int g, int t0, bool isctx) {
    const int tid = threadIdx.x;
    const float* P = (const float*)(p.ws + WS_P);
    const float* RC = (const float*)(p.ws + WS_ROPE);
    const float* RS = RC + 1024;
    float* Ks = (float*)lds;
    float* Vs = Ks + 32 * 64;
    const int tok = tid >> 3, dh = tid & 7;
    const int tq = t0 + tok;
    const int qrow = isctx ? NL + b * CTX + tq : b * S + tq;
    float q[4][8], o[4][8], m[4], lsum[4];
    {
        const int blk = dh >> 1;
        const int pos = blk < 2 ? (tq >> 6) : (tq & 63);
#pragma unroll
        for (int h = 0; h < 4; ++h) {
            const float* base = P + (size_t)qrow * NIN + OQ + (g * 4 + h) * 64;
            const float4 a0 = *(const float4*)(base + dh * 8), a1 = *(const float4*)(base + dh * 8 + 4);
            const float4 b0 = *(const float4*)(base + (dh ^ 2) * 8), b1 = *(const float4*)(base + (dh ^ 2) * 8 + 4);
            const float ov[8] = {a0.x, a0.y, a0.z, a0.w, a1.x, a1.y, a1.z, a1.w};
            const float pv[8] = {b0.x, b0.y, b0.z, b0.w, b1.x, b1.y, b1.z, b1.w};
#pragma unroll
            for (int i = 0; i < 8; ++i) {
                float r = ov[i];
                if (!isctx) {
                    const int f = (dh & 1) * 8 + i;
                    const float c = RC[pos * 16 + f], s = RS[pos * 16 + f];
                    r = (blk & 1) ? (ov[i] * c + pv[i] * s) : (ov[i] * c - pv[i] * s);
                }
                q[h][i] = r * 0.125f;
                o[h][i] = 0.f;
            }
            m[h] = p.in[I_SINK][l * 8 + g * 4 + h];
            lsum[h] = 1.f;
        }
    }
    int wstart = 0, wend = 0;
    if (!isctx) { wstart = t0 - 128 < 0 ? 0 : t0 - 128; wend = t0 + 32 + 128 > S ? S : t0 + 32 + 128; }
    const int nwt = (wend - wstart) >> 5;
    const int kk_l = tid >> 3, dq = tid & 7;
    for (int tile = 0; tile < 8 + nwt; ++tile) {
        const bool cx = tile < 8;
        const int tk0 = cx ? tile * 32 : wstart + (tile - 8) * 32;
        __syncthreads();
        {
            const int tk = tk0 + kk_l;
            const int krow = cx ? NL + b * CTX + tk : b * S + tk;
            const float* kb = P + (size_t)krow * NIN + OKK + g * 64;
            const float* vb = P + (size_t)krow * NIN + OV + g * 64;
            const float4 k0 = *(const float4*)(kb + dq * 8), k1 = *(const float4*)(kb + dq * 8 + 4);
            float kv[8] = {k0.x, k0.y, k0.z, k0.w, k1.x, k1.y, k1.z, k1.w};
            if (!cx) {
                const float4 p0 = *(const float4*)(kb + (dq ^ 2) * 8), p1 = *(const float4*)(kb + (dq ^ 2) * 8 + 4);
                const float pv[8] = {p0.x, p0.y, p0.z, p0.w, p1.x, p1.y, p1.z, p1.w};
                const int blk = dq >> 1;
                const int pos = blk < 2 ? (tk >> 6) : (tk & 63);
#pragma unroll
                for (int i = 0; i < 8; ++i) {
                    const int f = (dq & 1) * 8 + i;
                    const float c = RC[pos * 16 + f], s = RS[pos * 16 + f];
                    kv[i] = (blk & 1) ? (kv[i] * c + pv[i] * s) : (kv[i] * c - pv[i] * s);
                }
            }
            *(float4*)(Ks + kk_l * 64 + dq * 8) = make_float4(kv[0], kv[1], kv[2], kv[3]);
            *(float4*)(Ks + kk_l * 64 + dq * 8 + 4) = make_float4(kv[4], kv[5], kv[6], kv[7]);
            *(float4*)(Vs + kk_l * 64 + dq * 8) = *(const float4*)(vb + dq * 8);
            *(float4*)(Vs + kk_l * 64 + dq * 8 + 4) = *(const float4*)(vb + dq * 8 + 4);
        }
        __syncthreads();
        for (int kk = 0; kk < 32; ++kk) {
            const float4 ka = *(const float4*)(Ks + kk * 64 + dh * 8), kb2 = *(const float4*)(Ks + kk * 64 + dh * 8 + 4);
            float s[4];
#pragma unroll
            for (int h = 0; h < 4; ++h) {
                s[h] = q[h][0] * ka.x + q[h][1] * ka.y + q[h][2] * ka.z + q[h][3] * ka.w + q[h][4] * kb2.x + q[h][5] * kb2.y + q[h][6] * kb2.z + q[h][7] * kb2.w;
                s[h] += __shfl_xor(s[h], 1); s[h] += __shfl_xor(s[h], 2); s[h] += __shfl_xor(s[h], 4);
            }
            const int dlt = tq - (tk0 + kk);
            const bool valid = cx || (dlt <= 128 && dlt >= -128);
            const float4 va = *(const float4*)(Vs + kk * 64 + dh * 8), vb2 = *(const float4*)(Vs + kk * 64 + dh * 8 + 4);
#pragma unroll
            for (int h = 0; h < 4; ++h) {
                const float sv = valid ? s[h] : -1e30f;
                const float mn = fmaxf(m[h], sv);
                const float corr = __expf(m[h] - mn);
                const float pp = __expf(sv - mn);
                lsum[h] = lsum[h] * corr + pp;
                m[h] = mn;
                o[h][0] = o[h][0] * corr + pp * va.x; o[h][1] = o[h][1] * corr + pp * va.y; o[h][2] = o[h][2] * corr + pp * va.z; o[h][3] = o[h][3] * corr + pp * va.w;
                o[h][4] = o[h][4] * corr + pp * vb2.x; o[h][5] = o[h][5] * corr + pp * vb2.y; o[h][6] = o[h][6] * corr + pp * vb2.z; o[h][7] = o[h][7] * corr + pp * vb2.w;
            }
        }
    }
    float* ATT = (float*)(p.ws + WS_ATT);
#pragma unroll
    for (int h = 0; h < 4; ++h) {
        const float inv = 1.f / lsum[h];
        float* dst = ATT + (size_t)qrow * 512 + (g * 4 + h) * 64 + dh * 8;
        *(float4*)(dst) = make_float4(o[h][0] * inv, o[h][1] * inv, o[h][2] * inv, o[h][3] * inv);
        *(float4*)(dst + 4) = make_float4(o[h][4] * inv, o[h][5] * inv, o[h][6] * inv, o[h][7] * inv);
    }
    __syncthreads();
}

__device__ __forceinline__ void conv_item(const Params& p, int l, int ci) {
    const int tid = threadIdx.x;
    const float* P = (const float*)(p.ws + WS_P);
    float* U = (float*)(p.ws + WS_U);
    const int row0 = ci * 16;
    int s0, s1;
    if (row0 < NL) { s0 = (row0 >> 12) << 12; s1 = s0 + S; } else { s0 = NL + (((row0 - NL) >> 8) << 8); s1 = s0 + CTX; }
#pragma unroll
    for (int j = 0; j < 3; ++j) {
        const int c = tid + 256 * j;
        float cw[5];
#pragma unroll
        for (int w = 0; w < 5; ++w) cw[w] = p.in[I_CONVW][(l * 5 + w) * 768 + c];
        const float cb = p.in[I_CONVB][l * 768 + c];
        float v[20];
#pragma unroll
        for (int i = 0; i < 20; ++i) {
            const int rr = row0 - 2 + i;
            v[i] = (rr >= s0 && rr < s1) ? P[(size_t)rr * NIN + OXBC + c] : 0.f;
        }
#pragma unroll
        for (int i = 0; i < 16; ++i) {
            const float a = cb + v[i] * cw[0] + v[i + 1] * cw[1] + v[i + 2] * cw[2] + v[i + 3] * cw[3] + v[i + 4] * cw[4];
            U[(size_t)(row0 + i) * 768 + c] = silu_f(a);
        }
    }
}

__device__ __forceinline__ void ph_attn_conv(const Params& p, int l, unsigned char* lds) {
    const int n_lat = NBATCH * 2 * (S / 32);
    const int n_ctx = (l == 0) ? NBATCH * 2 * (CTX / 32) : 0;
    const int n_conv = NT / 16;
    for (int it = blockIdx.x; it < n_lat + n_ctx + n_conv; it += gridDim.x) {
        if (it < n_lat) {
            const int b = it / 256, r = it % 256, g = r / 128, t0 = (r % 128) * 32;
            attn_item(p, l, lds, b, g, t0, false);
        } else if (it < n_lat + n_ctx) {
            const int i2 = it - n_lat, b = i2 / 16, r = i2 % 16, g = r / 8, t0 = (r % 8) * 32;
            attn_item(p, l, lds, b, g, t0, true);
        } else {
            conv_item(p, l, it - n_lat - n_ctx);
        }
    }
}

__device__ __forceinline__ int scan_row(int i, int b, int dir) {
    if (i < CTX) { const int t = dir ? CTX - 1 - i : i; return NL + b * CTX + t; }
    const int j = i - CTX; const int t = dir ? S - 1 - j : j; return b * S + t;
}
__device__ __forceinline__ void ph_scan(const Params& p, int l, unsigned char* lds) {
    const int tid = threadIdx.x;
    const float* P = (const float*)(p.ws + WS_P);
    const float* U = (const float*)(p.ws + WS_U);
    float* YS = (float*)(p.ws + WS_YS);
    float* xs = (float*)lds;
    float* Bs = xs + 4096;
    float* Cs = Bs + 4096;
    float* ys = Cs + 4096;
    float* dAs = ys + 4096;
    float* dts = dAs + 64;
    for (int it = blockIdx.x; it < 128; it += gridDim.x) {
        const int b = it >> 4, head = (it >> 1) & 7, dir = it & 1, g = head >> 2;
        const float a = -expf(p.in[I_ALOG][l * 16 + dir * 8 + head]);
        const float dtb = p.in[I_DTB][l * 16 + dir * 8 + head];
        float h[16];
#pragma unroll
        for (int i = 0; i < 16; ++i) h[i] = 0.f;
        const int pp = tid >> 2, nq = tid & 3;
        const int ls = tid >> 2, qd = tid & 3;
        for (int c = 0; c < (CTX + S) / 64; ++c) {
            const int row = scan_row(c * 64 + ls, b, dir);
            __syncthreads();
            {
                const float* ur = U + (size_t)row * 768;
#pragma unroll
                for (int i4 = 0; i4 < 4; ++i4) {
                    *(float4*)(xs + ls * 64 + qd * 16 + i4 * 4) = *(const float4*)(ur + head * 64 + qd * 16 + i4 * 4);
                    *(float4*)(Bs + ls * 64 + qd * 16 + i4 * 4) = *(const float4*)(ur + 512 + g * 64 + qd * 16 + i4 * 4);
                    *(float4*)(Cs + ls * 64 + qd * 16 + i4 * 4) = *(const float4*)(ur + 640 + g * 64 + qd * 16 + i4 * 4);
                }
                if (qd == 0) {
                    const float raw = P[(size_t)row * NIN + ODT + dir * 8 + head] + dtb;
                    const float dt = fmaxf(raw, 0.f) + log1pf(expf(-fabsf(raw)));
                    dts[ls] = dt; dAs[ls] = expf(dt * a);
                }
            }
            __syncthreads();
            for (int s = 0; s < 64; ++s) {
                const float dA = dAs[s];
                const float xv = xs[s * 64 + pp] * dts[s];
                float y = 0.f;
#pragma unroll
                for (int i4 = 0; i4 < 4; ++i4) {
                    const float4 bv = *(const float4*)(Bs + s * 64 + nq * 16 + i4 * 4);
                    const float4 cv = *(const float4*)(Cs + s * 64 + nq * 16 + i4 * 4);
                    h[i4 * 4 + 0] = dA * h[i4 * 4 + 0] + xv * bv.x; y += cv.x * h[i4 * 4 + 0];
                    h[i4 * 4 + 1] = dA * h[i4 * 4 + 1] + xv * bv.y; y += cv.y * h[i4 * 4 + 1];
                    h[i4 * 4 + 2] = dA * h[i4 * 4 + 2] + xv * bv.z; y += cv.z * h[i4 * 4 + 2];
                    h[i4 * 4 + 3] = dA * h[i4 * 4 + 3] + xv * bv.w; y += cv.w * h[i4 * 4 + 3];
                }
                y += __shfl_xor(y, 1); y += __shfl_xor(y, 2);
                if (nq == 0) ys[s * 64 + pp] = y;
            }
            __syncthreads();
            {
                float* yr = YS + ((size_t)dir * NT + row) * 512 + head * 64 + qd * 16;
#pragma unroll
                for (int i4 = 0; i4 < 4; ++i4) *(float4*)(yr + i4 * 4) = *(const float4*)(ys + ls * 64 + qd * 16 + i4 * 4);
            }
        }
        __syncthreads();
    }
}

__device__ __forceinline__ void ph_prep_out(const Params& p, int l) {
    const int tid = threadIdx.x, lane = tid & 63, gw = blockIdx.x * 4 + (tid >> 6), GW = gridDim.x * 4;
    const float* P = (const float*)(p.ws + WS_P);
    const float* U = (const float*)(p.ws + WS_U);
    const float* ATT = (const float*)(p.ws + WS_ATT);
    const float* YS = (const float*)(p.ws + WS_YS);
    bf16_t* MIX = (bf16_t*)(p.ws + WS_MIX);
    const int nrows = (l == 0) ? NT : NL;
    for (int row = gw; row < nrows; row += GW) {
        float4 av[2];
        float ss = 0.f;
#pragma unroll
        for (int j = 0; j < 2; ++j) {
            av[j] = *(const float4*)(ATT + (size_t)row * 512 + j * 256 + lane * 4);
            ss += av[j].x * av[j].x + av[j].y * av[j].y + av[j].z * av[j].z + av[j].w * av[j].w;
        }
        ss = wave_sum(ss);
        const float rstd = rsqrtf(ss * (1.f / 512.f) + EPS);
#pragma unroll
        for (int j = 0; j < 2; ++j) {
            const int k = j * 256 + lane * 4;
            const float4 w = *(const float4*)(p.in[I_ATTNW] + l * 512 + k);
            uint2 o; o.x = pack2bf(av[j].x * rstd * w.x, av[j].y * rstd * w.y); o.y = pack2bf(av[j].z * rstd * w.z, av[j].w * rstd * w.w);
            *(uint2*)(MIX + (size_t)row * 1024 + k) = o;
        }
#pragma unroll
        for (int j = 0; j < 2; ++j) {
            const int ch = j * 256 + lane * 4;
            const float dsk = p.in[I_DSKIP][l * 8 + (ch >> 6)];
            const float4 u = *(const float4*)(U + (size_t)row * 768 + ch);
            const float4 y0 = *(const float4*)(YS + (size_t)row * 512 + ch);
            const float4 y1 = *(const float4*)(YS + ((size_t)NT + row) * 512 + ch);
            const float4 z = *(const float4*)(P + (size_t)row * NIN + OZ + ch);
            float gv[4];
            gv[0] = (dsk * u.x + y0.x + y1.x) * silu_f(z.x);
            gv[1] = (dsk * u.y + y0.y + y1.y) * silu_f(z.y);
            gv[2] = (dsk * u.z + y0.z + y1.z) * silu_f(z.z);
            gv[3] = (dsk * u.w + y0.w + y1.w) * silu_f(z.w);
            float s2 = gv[0] * gv[0] + gv[1] * gv[1] + gv[2] * gv[2] + gv[3] * gv[3];
            s2 = wave_sum(s2);
            const float r2 = rsqrtf(s2 * (1.f / 256.f) + EPS);
            const float4 w = *(const float4*)(p.in[I_SSMNW] + l * 512 + ch);
            uint2 o; o.x = pack2bf(gv[0] * r2 * w.x, gv[1] * r2 * w.y); o.y = pack2bf(gv[2] * r2 * w.z, gv[3] * r2 * w.w);
            *(uint2*)(MIX + (size_t)row * 1024 + 512 + ch) = o;
        }
    }
}

__device__ __forceinline__ void ph_outproj(const Params& p, int l, unsigned char* lds) {
    const bf16_t* MIX = (const bf16_t*)(p.ws + WS_MIX);
    const bf16_t* W = (const bf16_t*)(p.ws + WS_WOUT) + (size_t)l * 1024 * 1024;
    const float* MOD = (const float*)(p.ws + WS_MOD);
    float* XW = (float*)(p.ws + WS_XW);
    const int ntm = ((l == 0) ? NT : NL) / 128;
    for (int it = blockIdx.x; it < ntm * 8; it += gridDim.x) {
        const int mt = it / 8, nt = it % 8;
        const bf16_t* A0 = MIX + (size_t)mt * 128 * 1024;
        const float* g1 = MOD + (size_t)(l * 9 + mod_row(mt * 128)) * 6144 + 2048 + nt * 128;
        float* X0 = XW + (size_t)mt * 128 * 1024 + nt * 128;
        gemm_tile<1>(lds, RowDense{A0}, W + (size_t)nt * 128 * 1024, nullptr, EpiResid{X0, g1});
    }
}

__device__ __forceinline__ void ph_prep2(const Params& p, int l) {
    const int tid = threadIdx.x, lane = tid & 63, gw = blockIdx.x * 4 + (tid >> 6), GW = gridDim.x * 4;
    const float* XW = (const float*)(p.ws + WS_XW);
    bf16_t* H = (bf16_t*)(p.ws + WS_H);
    const float* MOD = (const float*)(p.ws + WS_MOD);
    const float* nw = p.in[I_NFFN] + l * 1024;
    const float* wr = p.in[I_WR] + (size_t)l * 1024 * 32;
    const float* br = p.in[I_BR] + l * 32;
    int* cnt = (int*)(p.ws + WS_CNT) + l * 32;
    int* list = (int*)(p.ws + WS_LIST);
    int* route = (int*)(p.ws + WS_ROUTE);
    float* gate = (float*)(p.ws + WS_GATE);
    const int nrows = (l == 0) ? NT : NL;
    for (int row = gw; row < nrows; row += GW) {
        const int mr = mod_row(row);
        float ss = 0.f;
#pragma unroll
        for (int j = 0; j < 4; ++j) {
            const float4 x4 = *(const float4*)(XW + (size_t)row * 1024 + j * 256 + lane * 4);
            ss += x4.x * x4.x + x4.y * x4.y + x4.z * x4.z + x4.w * x4.w;
        }
        ss = wave_sum(ss);
        const float rstd = rsqrtf(ss * (1.f / 1024.f) + EPS);
        const float* sh = MOD + (size_t)(l * 9 + mr) * 6144 + 3072;
        const float* sc = sh + 1024;
        float lg[32];
#pragma unroll
        for (int e = 0; e < 32; ++e) lg[e] = 0.f;
#pragma unroll 1
        for (int j = 0; j < 4; ++j) {
            const int k = j * 256 + lane * 4;
            const float4 x4 = *(const float4*)(XW + (size_t)row * 1024 + k);
            const float4 w = *(const float4*)(nw + k), a = *(const float4*)(sc + k), b = *(const float4*)(sh + k);
            float hv[4];
            hv[0] = x4.x * rstd * w.x * (1.f + a.x) + b.x; hv[1] = x4.y * rstd * w.y * (1.f + a.y) + b.y;
            hv[2] = x4.z * rstd * w.z * (1.f + a.z) + b.z; hv[3] = x4.w * rstd * w.w * (1.f + a.w) + b.w;
            uint2 o; o.x = pack2bf(hv[0], hv[1]); o.y = pack2bf(hv[2], hv[3]);
            *(uint2*)(H + (size_t)row * 1024 + k) = o;
#pragma unroll
            for (int i = 0; i < 4; ++i) {
                const float* wrow = wr + (size_t)(k + i) * 32;
#pragma unroll
                for (int e4 = 0; e4 < 8; ++e4) {
                    const float4 wv = *(const float4*)(wrow + e4 * 4);
                    lg[e4 * 4 + 0] += hv[i] * wv.x; lg[e4 * 4 + 1] += hv[i] * wv.y; lg[e4 * 4 + 2] += hv[i] * wv.z; lg[e4 * 4 + 3] += hv[i] * wv.w;
                }
            }
        }
#pragma unroll
        for (int e = 0; e < 32; ++e) lg[e] = wave_sum(lg[e]) + br[e];
        unsigned taken = 0u;
        float tv[4]; int ti[4];
#pragma unroll
        for (int k = 0; k < 4; ++k) {
            float best = -3.0e38f; int bi = 0;
#pragma unroll
            for (int e = 0; e < 32; ++e) {
                const bool ok = !((taken >> e) & 1u) && lg[e] > best;
                best = ok ? lg[e] : best; bi = ok ? e : bi;
            }
            taken |= 1u << bi; tv[k] = best; ti[k] = bi;
        }
        const float e1 = __expf(tv[1] - tv[0]), e2 = __expf(tv[2] - tv[0]), e3 = __expf(tv[3] - tv[0]);
        const float inv = 1.f / (1.f + e1 + e2 + e3);
        if (lane < 4) {
            const int ek = lane == 0 ? ti[0] : lane == 1 ? ti[1] : lane == 2 ? ti[2] : ti[3];
            const float gk = (lane == 0 ? 1.f : lane == 1 ? e1 : lane == 2 ? e2 : e3) * inv;
            const int slot = atomicAdd(&cnt[ek], 1);
            list[(size_t)ek * NT + slot] = row;
            route[row * 4 + lane] = (ek << 16) | slot;
            gate[row * 4 + lane] = gk;
        }
    }
}

struct MoeSched { int e, mt, cnt, rowbase; bool ok; };
__device__ __forceinline__ MoeSched moe_find(const int* cnt, int tile) {
    MoeSched s; s.ok = false; s.e = 0; s.mt = 0; s.cnt = 0; s.rowbase = 0;
    int acc = 0;
    for (int e = 0; e < NE; ++e) {
        const int c = cnt[e], nt = (c + 127) >> 7;
        if (!s.ok && tile < acc + nt) { s.ok = true; s.e = e; s.mt = tile - acc; s.cnt = c; s.rowbase = acc * 128; }
        acc += nt;
    }
    return s;
}
__device__ __forceinline__ int moe_total_tiles(const int* cnt) {
    int acc = 0;
    for (int e = 0; e < NE; ++e) acc += (cnt[e] + 127) >> 7;
    return acc;
}

__device__ __forceinline__ void ph_moe1(const Params& p, int l, unsigned char* lds) {
    const int* cnt = (const int*)(p.ws + WS_CNT) + l * 32;
    const int* list = (const int*)(p.ws + WS_LIST);
    const bf16_t* H = (const bf16_t*)(p.ws + WS_H);
    bf16_t* ACT = (bf16_t*)(p.ws + WS_ACT);
    const int total = moe_total_tiles(cnt) * 8;
    for (int it = blockIdx.x; it < total; it += gridDim.x) {
        const MoeSched s = moe_find(cnt, it >> 3);
        const int nt = it & 7;
        const int* lst = list + (size_t)s.e * NT;
        const int m0 = s.mt * 128, cm1 = s.cnt - 1;
        const bf16_t* W = (const bf16_t*)(p.ws + WS_WGU) + (size_t)(l * 32 + s.e) * 2048 * 1024;
        const float* bg = p.in[I_BGU] + (size_t)(l * 32 + s.e) * 2048 + nt * 128;
        bf16_t* A0 = ACT + (size_t)(s.rowbase + m0) * 1024 + nt * 128;
        gemm_tile<2>(lds, RowGather{H, lst, m0, cm1}, W + (size_t)(nt * 128) * 1024, W + (size_t)(1024 + nt * 128) * 1024, EpiSwiglu{A0, bg});
    }
}

__device__ __forceinline__ void ph_moe2(const Params& p, int l, unsigned char* lds) {
    const int* cnt = (const int*)(p.ws + WS_CNT) + l * 32;
    const bf16_t* ACT = (const bf16_t*)(p.ws + WS_ACT);
    bf16_t* Y = (bf16_t*)(p.ws + WS_Y);
    const int total = moe_total_tiles(cnt) * 8;
    for (int it = blockIdx.x; it < total; it += gridDim.x) {
        const MoeSched s = moe_find(cnt, it >> 3);
        const int nt = it & 7;
        const bf16_t* W = (const bf16_t*)(p.ws + WS_WDN) + (size_t)(l * 32 + s.e) * 1024 * 1024;
        const float* bd = p.in[I_BDN] + (size_t)(l * 32 + s.e) * 1024 + nt * 128;
        const bf16_t* A0 = ACT + (size_t)(s.rowbase + s.mt * 128) * 1024;
        bf16_t* Y0 = Y + (size_t)(s.rowbase + s.mt * 128) * 1024 + nt * 128;
        gemm_tile<1>(lds, RowDense{A0}, W + (size_t)(nt * 128) * 1024, nullptr, EpiBiasBf16{Y0, bd});
    }
}

__device__ __forceinline__ void ph_final(const Params& p) {
    const int tid = threadIdx.x, lane = tid & 63, gw = blockIdx.x * 4 + (tid >> 6), GW = gridDim.x * 4;
    const float* XW = (const float*)(p.ws + WS_XW);
    const float* MOD = (const float*)(p.ws + WS_MOD);
    const bf16_t* Y = (const bf16_t*)(p.ws + WS_Y);
    const int mybase = expert_rowbase((const int*)(p.ws + WS_CNT) + 32, lane & 31);
    for (int row = gw; row < NL; row += GW) {
        const int mr = mod_row(row);
        const int* route = (const int*)(p.ws + WS_ROUTE) + row * 4;
        const float* gate = (const float*)(p.ws + WS_GATE) + row * 4;
        const float* g2 = MOD + (size_t)(1 * 9 + mr) * 6144 + 5120;
        float4 xv[4], fs[4];
#pragma unroll
        for (int j = 0; j < 4; ++j) { xv[j] = *(const float4*)(XW + (size_t)row * 1024 + j * 256 + lane * 4); fs[j] = make_float4(0.f, 0.f, 0.f, 0.f); }
#pragma unroll
        for (int k = 0; k < 4; ++k) {
            const int rt = route[k]; const float gk = gate[k];
            const int e = rt >> 16, slot = rt & 0xffff;
            const int pos = __shfl(mybase, e) + slot;
            const bf16_t* yr = Y + (size_t)pos * 1024;
#pragma unroll
            for (int j = 0; j < 4; ++j) {
                const uint2 w = *(const uint2*)(yr + j * 256 + lane * 4);
                fs[j].x += gk * bf2f((unsigned short)(w.x & 0xffff)); fs[j].y += gk * bf2f((unsigned short)(w.x >> 16));
                fs[j].z += gk * bf2f((unsigned short)(w.y & 0xffff)); fs[j].w += gk * bf2f((unsigned short)(w.y >> 16));
            }
        }
        float ss = 0.f;
#pragma unroll
        for (int j = 0; j < 4; ++j) {
            const float4 g = *(const float4*)(g2 + j * 256 + lane * 4);
            xv[j].x += g.x * fs[j].x; xv[j].y += g.y * fs[j].y; xv[j].z += g.z * fs[j].z; xv[j].w += g.w * fs[j].w;
            ss += xv[j].x * xv[j].x + xv[j].y * xv[j].y + xv[j].z * xv[j].z + xv[j].w * xv[j].w;
        }
        ss = wave_sum(ss);
        const float rstd = rsqrtf(ss * (1.f / 1024.f) + EPS);
#pragma unroll
        for (int j = 0; j < 4; ++j) {
            const int k = j * 256 + lane * 4;
            const float4 w = *(const float4*)(p.in[I_FNW] + k);
            *(float4*)(p.out + (size_t)row * 1024 + k) = make_float4(xv[j].x * rstd * w.x, xv[j].y * rstd * w.y, xv[j].z * rstd * w.z, xv[j].w * rstd * w.w);
        }
    }
}

constexpr int N_PHASES = 20;
__global__ void __launch_bounds__(NTHR, 2) fwd(Params p) {
    extern __shared__ __attribute__((aligned(16))) unsigned char lds[];
    const int lo = p.ph_lo, hi = p.ph_hi;
#define PH(k, call) if (lo <= (k) && (k) < hi) { if ((k) > lo) cg::this_grid().sync(); call; }
    PH(0, ph_setup(p, lds))
    PH(1, ph_prep1(p, 0))
    PH(2, ph_inproj(p, 0, lds))
    PH(3, ph_attn_conv(p, 0, lds))
    PH(4, ph_scan(p, 0, lds))
    PH(5, ph_prep_out(p, 0))
    PH(6, ph_outproj(p, 0, lds))
    PH(7, ph_prep2(p, 0))
    PH(8, ph_moe1(p, 0, lds))
    PH(9, ph_moe2(p, 0, lds))
    PH(10, ph_prep1(p, 1))
    PH(11, ph_inproj(p, 1, lds))
    PH(12, ph_attn_conv(p, 1, lds))
    PH(13, ph_scan(p, 1, lds))
    PH(14, ph_prep_out(p, 1))
    PH(15, ph_outproj(p, 1, lds))
    PH(16, ph_prep2(p, 1))
    PH(17, ph_moe1(p, 1, lds))
    PH(18, ph_moe2(p, 1, lds))
    PH(19, ph_final(p))
#undef PH
}

extern "C" void kernel_launch(void* const* d_in, const int* in_sizes, int n_in, void* d_out, int out_size, void* d_ws, size_t ws_size, hipStream_t stream) {
    static int grid = 0;
    if (grid == 0) {
        if (n_in != 25 || ws_size < WS_END) { fprintf(stderr, "kernel_launch: unexpected n_in %d or ws_size %zu < %zu\n", n_in, ws_size, (size_t)WS_END); grid = -1; return; }
        int dev = 0, cus = 0, per_cu = 0;
        hipGetDevice(&dev);
        hipDeviceGetAttribute(&cus, hipDeviceAttributeMultiprocessorCount, dev);
        hipFuncSetAttribute((const void*)fwd, hipFuncAttributeMaxDynamicSharedMemorySize, LDS_BYTES);
        hipOccupancyMaxActiveBlocksPerMultiprocessor(&per_cu, (const void*)fwd, NTHR, LDS_BYTES);
        if (per_cu < 1) per_cu = 1;
        if (per_cu > 2) per_cu = 2;
        grid = cus * per_cu;
        fprintf(stderr, "kernel_launch: grid %d (%d per CU), ws need %zu have %zu\n", grid, per_cu, (size_t)WS_END, ws_size);
    }
    if (grid < 0) return;
    Params p{};
    for (int i = 0; i < 25; ++i) p.in[i] = (const float*)d_in[i];
    p.out = (float*)d_out; p.ws = (unsigned char*)d_ws;
#if N_LAUNCH_MODE == 0
    for (int ph = 0; ph < N_PHASES; ++ph) {
        p.ph_lo = ph; p.ph_hi = ph + 1;
        hipLaunchKernelGGL(fwd, dim3(grid), dim3(NTHR), LDS_BYTES, stream, p);
    }
#else
    p.ph_lo = 0; p.ph_hi = N_PHASES;
    void* args[] = {&p};
    hipError_t e = hipLaunchCooperativeKernel((const void*)fwd, dim3(grid), dim3(NTHR), args, LDS_BYTES, stream);
    if (e != hipSuccess) fprintf(stderr, "cooperative launch failed: %s (grid %d)\n", hipGetErrorString(e), grid);
#endif
}
```

```cpp
#include <hip/hip_runtime.h>
#include <hip/hip_cooperative_groups.h>
#include <cstdio>
#include <cstdint>
#include <cstddef>
namespace cg = cooperative_groups;

typedef unsigned short bf16_t;
typedef short bf16x8 __attribute__((ext_vector_type(8)));
typedef float f32x4 __attribute__((ext_vector_type(4)));
typedef unsigned u32x4 __attribute__((ext_vector_type(4)));
typedef int i32x8 __attribute__((ext_vector_type(8)));
typedef int i32x4 __attribute__((ext_vector_type(4)));

#ifndef N_LAUNCH_MODE
#define N_LAUNCH_MODE 1
#endif

constexpr int D = 1024, NBATCH = 8, S = 4096, CTX = 256;
constexpr int NL = NBATCH * S, NC = NBATCH * CTX, NT = NL + NC;
constexpr int NIN = 2176, NINV = 2064;
constexpr int NP = 2048;
constexpr int OQ = 0, OKK = 512, OV = 640, OZ = 768, OXBC = 1280, ODT = 2048;
constexpr int NE = 32;
constexpr int ACT_ROWS = NT * 4 + NE * 256;
constexpr float EPS = 1e-6f;
constexpr int NTHR = 512, NWAVE = 8;
constexpr int LDS_BYTES = 152 * 1024;

constexpr size_t al256(size_t x) { return (x + 65536 + 255) & ~(size_t)255; }
constexpr size_t WS_CTL   = 0;
constexpr size_t WS_CNT   = 65536;
constexpr size_t WS_ROPE  = WS_CNT + 4096;
constexpr size_t WS_C9    = WS_ROPE + 8192;
constexpr size_t WS_WRT   = WS_C9 + 4096;
constexpr size_t WS_MOD   = WS_WRT + (size_t)2 * 2 * 32 * 1024 * 2;
constexpr size_t WS_WIN   = al256(WS_MOD + (size_t)2 * 9 * 6144 * 4);
constexpr size_t WS_WOUT  = al256(WS_WIN + (size_t)2 * NIN * 1024 * 2);
constexpr size_t WS_WGU   = al256(WS_WOUT + (size_t)2 * 1024 * 1024 * 2);
constexpr size_t WS_WDN   = al256(WS_WGU + (size_t)64 * 2048 * 1024);
constexpr size_t WS_H     = al256(WS_WDN + (size_t)64 * 1024 * 1024);
constexpr size_t WS_P     = al256(WS_H + (size_t)NT * 1024 * 2);
constexpr size_t WS_DT    = al256(WS_P + (size_t)NT * NP * 4);
constexpr int NBLK = 34, NITEM = NBATCH * NBLK * 2;
constexpr int TPB = CTX + S;
constexpr size_t DT_STRIDE = (size_t)NT * 16 * 4 + 65536;
constexpr size_t WS_QB    = al256(WS_DT + 2 * DT_STRIDE);
constexpr size_t WS_KB    = al256(WS_QB + (size_t)NT * 512 * 2);
constexpr size_t WS_VT    = al256(WS_KB + (size_t)NT * 128 * 2);
constexpr size_t WS_UXT   = al256(WS_VT + (size_t)NBATCH * 2 * 64 * TPB * 2);
constexpr size_t WS_UBN   = al256(WS_UXT + (size_t)NITEM * 256 * 128 * 2);
constexpr size_t WS_UCN   = al256(WS_UBN + (size_t)NITEM * 128 * 64 * 2);
constexpr size_t WS_ST    = al256(WS_UCN + (size_t)NITEM * 128 * 64 * 2);
constexpr size_t WS_DEC   = al256(WS_ST + (size_t)128 * NBLK * 4096 * 4);
constexpr size_t DEC_STRIDE = (size_t)128 * NBLK * 4 + 65536;
constexpr size_t WS_HS    = al256(WS_DEC + 2 * DEC_STRIDE);
constexpr size_t WS_ATT   = al256(WS_HS + (size_t)128 * NBLK * 4096 * 2);
constexpr size_t WS_MIX   = al256(WS_ATT + (size_t)NT * 512 * 4);
constexpr size_t WS_XW    = al256(WS_MIX + (size_t)NT * 1024 * 2);
constexpr size_t WS_LIST  = al256(WS_XW + (size_t)NT * 1024 * 4);
constexpr size_t LIST_STRIDE = (size_t)NE * NT * 4 + 65536;
constexpr size_t WS_ROUTE = al256(WS_LIST + 2 * LIST_STRIDE);
constexpr size_t RG_STRIDE = (size_t)NT * 4 * 4 + 65536;
constexpr size_t WS_GATE  = al256(WS_ROUTE + 2 * RG_STRIDE);
constexpr size_t WS_ACT   = al256(WS_GATE + 2 * RG_STRIDE);
constexpr size_t WS_Y     = al256(WS_ACT + (size_t)ACT_ROWS * 1024);
constexpr size_t WS_END   = al256(WS_Y + (size_t)ACT_ROWS * 1024 * 2);

struct Params {
    const float* in[25];
    float* out;
    unsigned char* ws;
    int ph_lo, ph_hi;
};
enum { I_X = 0, I_C, I_CTX, I_CCTX, I_WADA, I_BADA, I_NMIX, I_NFFN, I_WIN, I_CONVW, I_CONVB, I_DTB, I_ALOG, I_DSKIP, I_SSMNW, I_SINK,
       I_ATTNW, I_WOUT, I_WR, I_BR, I_WGU, I_BGU, I_WDN, I_BDN, I_FNW };

typedef __bf16 hwbf16x2 __attribute__((ext_vector_type(2)));
typedef float hwf32x2 __attribute__((ext_vector_type(2)));
__device__ __forceinline__ unsigned pack2bf(float lo, float hi) { const hwf32x2 v = {lo, hi}; return __builtin_bit_cast(unsigned, __builtin_convertvector(v, hwbf16x2)); }
__device__ __forceinline__ unsigned short f2bf(float f) { return (unsigned short)(pack2bf(f, f) & 0xffffu); }
__device__ __forceinline__ float bf2f(unsigned short h) { return __uint_as_float((unsigned)h << 16); }
__device__ __forceinline__ f32x4 quad_transpose(const f32x4 x, int t) {
    const bool odd = (t & 1) != 0, hi = (t & 2) != 0;
    float p[4], b[4], q[4];
#pragma unroll
    for (int j = 0; j < 4; ++j) p[j] = __int_as_float(__builtin_amdgcn_mov_dpp(__float_as_int(x[j]), 0xB1, 0xF, 0xF, true));
    b[0] = odd ? p[1] : x[0]; b[1] = odd ? x[1] : p[0]; b[2] = odd ? p[3] : x[2]; b[3] = odd ? x[3] : p[2];
#pragma unroll
    for (int j = 0; j < 4; ++j) q[j] = __int_as_float(__builtin_amdgcn_mov_dpp(__float_as_int(b[j]), 0x4E, 0xF, 0xF, true));
    f32x4 y;
    y[0] = hi ? q[2] : b[0]; y[1] = hi ? q[3] : b[1]; y[2] = hi ? b[2] : q[0]; y[3] = hi ? b[3] : q[1];
    return y;
}
__device__ __forceinline__ bf16x8 pack8bf(float a0, float a1, float a2, float a3, float a4, float a5, float a6, float a7) {
    const u32x4 w = {pack2bf(a0, a1), pack2bf(a2, a3), pack2bf(a4, a5), pack2bf(a6, a7)};
    return __builtin_bit_cast(bf16x8, w);
}
__device__ __forceinline__ unsigned pack4fp8(float a, float b, float c, float d) {
    unsigned w = 0u;
    w = __builtin_amdgcn_cvt_pk_fp8_f32(a, b, w, false);
    w = __builtin_amdgcn_cvt_pk_fp8_f32(c, d, w, true);
    return w;
}
constexpr float F8_WSCALE = 64.f, F8_ASCALE = 4.f, F8_OSCALE = 1.f / (64.f * 4.f), F8_YSCALE = 16.f;
__device__ __forceinline__ void st_wt(float* q, float v) { __hip_atomic_store(q, v, __ATOMIC_RELAXED, __HIP_MEMORY_SCOPE_AGENT); }
__device__ __forceinline__ void st_wt(int* q, int v) { __hip_atomic_store(q, v, __ATOMIC_RELAXED, __HIP_MEMORY_SCOPE_AGENT); }
__device__ __forceinline__ float silu_f(float x) { return x / (1.f + __expf(-x)); }
__device__ __forceinline__ float wave_sum(float v) {
#pragma unroll
    for (int o = 32; o >= 1; o >>= 1) v += __shfl_xor(v, o);
    return v;
}
__device__ __forceinline__ int mod_row(int row) { return row < NL ? (row >> 12) : 8; }

#define LAS __attribute__((address_space(3)))
namespace g8 {
constexpr int BM = 256, BK = 64, HALF = 128, HTB = HALF * BK * 2, KB = 1024 * 2  ;
__device__ __forceinline__ int lds_byte(int r, int c) { const int st = (r >> 4) * 2 + (c >> 5), rr = r & 15, cc = c & 31, ob = rr * 64 + cc * 2; return st * 1024 + (ob ^ (((ob >> 9) & 1) << 5)); }
__device__ __forceinline__ void stage_rc(int b, int& R, int& C) { const int st = b / 1024, sb = b % 1024, swz = sb ^ (((sb >> 9) & 1) << 5); R = (st >> 1) * 16 + swz / 64; C = (st & 1) * 32 + (swz % 64) / 2; }

struct Unit {
    const char* a0;
    const char* b0;
    int r0, c0;
    int e, m0, cm1;
};

__device__ __forceinline__ int perm32(int rho) { const int n = rho >> 4, i = rho & 15; return 8 * (i >> 2) + 4 * n + (i & 3); }
constexpr int GTAB_OFF = 8 * HTB;
constexpr int BTAB_OFF = GTAB_OFF + 1024;
constexpr int MTAB_OFF = BTAB_OFF + 3072;
template <bool GATHER, bool PERM, class Sched, class Epi>
__device__ __forceinline__ void gemm_phase(LAS unsigned char* lds, const Sched& S, const Epi& E) {
    const int tid = threadIdx.x, wid = __builtin_amdgcn_readfirstlane(tid >> 6), lane = tid & 63, wr = wid >> 2, wc = wid & 3, fr = lane & 15, fq = lane >> 4;
    constexpr int nt = 1024 / BK;
    int Rr[2], Cc[2];
    unsigned voffB[2], vA[2][2];
#pragma unroll
    for (int i = 0; i < 2; ++i) { stage_rc(tid * 16 + i * 8192, Rr[i], Cc[i]); const int Rb = PERM ? ((Rr[i] & ~31) + perm32(Rr[i] & 31)) : Rr[i]; voffB[i] = (unsigned)(Rb * 1024 + Cc[i]) * 2u; }
    constexpr size_t kstep = (size_t)BK * 2;
    const unsigned ldsw = (unsigned)wid * 1024u;
    const int aoff = lds_byte(wr * 64 + fr, fq * 8), boff = lds_byte(wc * 32 + fr, fq * 8);
#define G8_SA(b, h) (((b) * 2 + (h)) * HTB)
#define G8_SB(b, h) ((4 + (b) * 2 + (h)) * HTB)
#define G8_STAGE(bufoff, gbase, voff) do { _Pragma("unroll") for (int _i = 0; _i < 2; ++_i) \
        __builtin_amdgcn_global_load_lds((const unsigned*)((const char*)(gbase) + (voff)[_i]), (LAS unsigned*)(lds + (bufoff) + ldsw + _i * 8192), 16, 0, 0); } while (0)
#define G8_LDA(dst, b, h) do { _Pragma("unroll") for (int m = 0; m < 4; ++m) _Pragma("unroll") for (int k = 0; k < 2; ++k) dst[m][k] = *(const LAS bf16x8*)(lds + G8_SA(b, h) + aoff + m * 2048 + k * 1024); } while (0)
#define G8_LDB(dst, b, h) do { _Pragma("unroll") for (int n = 0; n < 2; ++n) _Pragma("unroll") for (int k = 0; k < 2; ++k) dst[n][k] = *(const LAS bf16x8*)(lds + G8_SB(b, h) + boff + n * 2048 + k * 1024); } while (0)
#define G8_MMA(ai, bj, At, Bt) do { __builtin_amdgcn_s_setprio(1); _Pragma("unroll") for (int m = 0; m < 4; ++m) _Pragma("unroll") for (int n = 0; n < 2; ++n) _Pragma("unroll") for (int k = 0; k < 2; ++k) \
        acc[ai][bj][m][n] = __builtin_amdgcn_mfma_f32_16x16x32_bf16(Bt[n][k], At[m][k], acc[ai][bj][m][n], 0, 0, 0); __builtin_amdgcn_s_setprio(0); } while (0)
#define G8_WAIT_V(n) asm volatile("s_waitcnt vmcnt(" #n ")" ::: "memory")
#define G8_WAIT_L(n) asm volatile("s_waitcnt lgkmcnt(" #n ")" ::: "memory")
#define G8_BAR __builtin_amdgcn_s_barrier()
#define G8_SCHED __builtin_amdgcn_sched_barrier(0)
    Unit cur, nxt; int ui = 0;
    if (!S.next(0, cur)) return;
#pragma unroll
    for (int h = 0; h < 2; ++h)
#pragma unroll
        for (int i = 0; i < 2; ++i) vA[h][i] = GATHER ? S.aoff(cur, h, Rr[i], Cc[i]) : (unsigned)(Rr[i] * 1024 + Cc[i]) * 2u;
    f32x4 acc[2][2][4][2];
#pragma unroll
    for (int a = 0; a < 2; ++a)
#pragma unroll
        for (int b = 0; b < 2; ++b)
#pragma unroll
            for (int m = 0; m < 4; ++m)
#pragma unroll
                for (int n = 0; n < 2; ++n) acc[a][b][m][n] = (f32x4){0.f, 0.f, 0.f, 0.f};
    bf16x8 At[4][2], B0[2][2], B1[2][2];
    G8_STAGE(G8_SB(0, 0), cur.b0, voffB); G8_STAGE(G8_SA(0, 0), cur.a0, vA[0]); G8_STAGE(G8_SB(0, 1), (cur.b0 + Sched::B1OFF), voffB); G8_STAGE(G8_SA(0, 1), (cur.a0 + Sched::A1OFF), vA[1]);
    if (wr == 1) G8_BAR;
    G8_WAIT_V(4); G8_BAR;
    G8_STAGE(G8_SB(1, 0), cur.b0 + kstep, voffB); G8_STAGE(G8_SA(1, 0), cur.a0 + kstep, vA[0]); G8_STAGE(G8_SB(1, 1), (cur.b0 + Sched::B1OFF) + kstep, voffB);
    G8_WAIT_V(6); G8_BAR;
    for (;;) {
        const bool has_next = S.next(ui + 1, nxt);
        if (!has_next) nxt = cur;
        if (GATHER && has_next)
            __builtin_amdgcn_global_load_lds((const unsigned*)(S.list_ptr(nxt) + (wid & 3) * 64 + lane), (LAS unsigned*)(lds + GTAB_OFF + (wid & 3) * 256), 4, 0, 0);
#pragma unroll 1
        for (int t = 0; t < nt; t += 2) {
            const bool last = (t == nt - 2);
            const char* a1h1 = (cur.a0 + Sched::A1OFF) + (size_t)(t + 1) * kstep;
            const char* a2h0 = last ? nxt.a0 : cur.a0 + (size_t)(t + 2) * kstep; const char* a2h1 = last ? (nxt.a0 + Sched::A1OFF) : (cur.a0 + Sched::A1OFF) + (size_t)(t + 2) * kstep;
            const char* b2h0 = last ? nxt.b0 : cur.b0 + (size_t)(t + 2) * kstep; const char* b2h1 = last ? (nxt.b0 + Sched::B1OFF) : (cur.b0 + Sched::B1OFF) + (size_t)(t + 2) * kstep;
            G8_LDB(B0, 0, 0); G8_SCHED; G8_LDA(At, 0, 0); G8_STAGE(G8_SA(1, 1), a1h1, vA[1]);
            if (GATHER && last && has_next) {
                const int lim = nxt.cm1 - nxt.m0;
#pragma unroll
                for (int h = 0; h < 2; ++h)
#pragma unroll
                    for (int i = 0; i < 2; ++i) { int ix = h * 128 + Rr[i]; ix = ix > lim ? lim : ix;
                        vA[h][i] = (unsigned)(*(const LAS int*)(lds + GTAB_OFF + ix * 4)) * (unsigned)KB + (unsigned)Cc[i] * 2u; }
            }
            G8_WAIT_L(8); G8_BAR; G8_WAIT_L(0); G8_MMA(0, 0, At, B0); G8_BAR; G8_SCHED;
            G8_LDB(B1, 0, 1); G8_STAGE(G8_SB(0, 0), b2h0, voffB);
            G8_BAR; G8_WAIT_L(0); G8_MMA(0, 1, At, B1); G8_BAR;
            G8_LDA(At, 0, 1); G8_STAGE(G8_SA(0, 0), a2h0, vA[0]);
            G8_BAR; G8_WAIT_L(0); G8_MMA(1, 0, At, B0); G8_BAR; G8_SCHED;
            G8_STAGE(G8_SB(0, 1), b2h1, voffB);
            G8_WAIT_V(6); G8_BAR; G8_MMA(1, 1, At, B1); G8_BAR;
            G8_LDB(B0, 1, 0); G8_SCHED; G8_LDA(At, 1, 0); G8_STAGE(G8_SA(0, 1), a2h1, vA[1]);
            G8_WAIT_L(8); G8_BAR; G8_WAIT_L(0); G8_MMA(0, 0, At, B0); G8_BAR; G8_SCHED;
            G8_LDB(B1, 1, 1); G8_STAGE(G8_SB(1, 0), b2h0 + kstep, voffB);
            G8_BAR; G8_WAIT_L(0); G8_MMA(0, 1, At, B1); G8_BAR;
            G8_LDA(At, 1, 1); G8_STAGE(G8_SA(1, 0), a2h0 + kstep, vA[0]);
            G8_BAR; G8_WAIT_L(0); G8_MMA(1, 0, At, B0); G8_BAR; G8_SCHED;
            G8_STAGE(G8_SB(1, 1), b2h1 + kstep, voffB);
            G8_WAIT_V(6); G8_BAR; G8_MMA(1, 1, At, B1); G8_BAR;
        }
        E(acc, cur, wr, wc, fr, fq);
        if (!has_next) break;
#pragma unroll
        for (int a = 0; a < 2; ++a)
#pragma unroll
            for (int b = 0; b < 2; ++b)
#pragma unroll
                for (int m = 0; m < 4; ++m)
#pragma unroll
                    for (int n = 0; n < 2; ++n) acc[a][b][m][n] = (f32x4){0.f, 0.f, 0.f, 0.f};
        cur = nxt; ++ui;
    }
    G8_WAIT_V(0);
    if (wr == 0) G8_BAR;
    G8_BAR;
#undef G8_SA
#undef G8_SB
#undef G8_STAGE
#undef G8_LDA
#undef G8_LDB
#undef G8_MMA
#undef G8_WAIT_V
#undef G8_WAIT_L
#undef G8_BAR
#undef G8_SCHED
}

template <bool GATHER, bool PERM, class Sched, class Epi>
__device__ __forceinline__ void gemm_phase_f8(LAS unsigned char* lds, const Sched& S, const Epi& E) {
    const int tid = threadIdx.x, wid = __builtin_amdgcn_readfirstlane(tid >> 6), lane = tid & 63, wr = wid >> 2, wc = wid & 3, fr = lane & 15, fq = lane >> 4;
    constexpr int nt = 8, ROWB = 1024;
    int Rr[2], Cc[2];
    unsigned voffB[2], vA[2][2];
#pragma unroll
    for (int i = 0; i < 2; ++i) { stage_rc(tid * 16 + i * 8192, Rr[i], Cc[i]); const int Rb = PERM ? ((Rr[i] & ~31) + perm32(Rr[i] & 31)) : Rr[i]; voffB[i] = (unsigned)(Rb * ROWB + Cc[i] * 2); }
    constexpr size_t kstep = (size_t)BK * 2;
    const unsigned ldsw = (unsigned)wid * 1024u;
    const int aoff = lds_byte(wr * 64 + fr, fq * 16), boff = lds_byte(wc * 32 + fr, fq * 16);
#define G8_SA(b, h) (((b) * 2 + (h)) * HTB)
#define G8_SB(b, h) ((4 + (b) * 2 + (h)) * HTB)
#define G8_STAGE(bufoff, gbase, voff) do { _Pragma("unroll") for (int _i = 0; _i < 2; ++_i) \
        __builtin_amdgcn_global_load_lds((const unsigned*)((const char*)(gbase) + (voff)[_i]), (LAS unsigned*)(lds + (bufoff) + ldsw + _i * 8192), 16, 0, 0); } while (0)
#define G8_LDA(dst, b, h) do { _Pragma("unroll") for (int m = 0; m < 4; ++m) { const u32x4 _lo = *(const LAS u32x4*)(lds + G8_SA(b, h) + aoff + m * 2048), _hi = *(const LAS u32x4*)(lds + G8_SA(b, h) + aoff + m * 2048 + 16); \
        dst[m] = __builtin_shufflevector(__builtin_bit_cast(i32x4, _lo), __builtin_bit_cast(i32x4, _hi), 0, 1, 2, 3, 4, 5, 6, 7); } } while (0)
#define G8_LDB(dst, b, h) do { _Pragma("unroll") for (int n = 0; n < 2; ++n) { const u32x4 _lo = *(const LAS u32x4*)(lds + G8_SB(b, h) + boff + n * 2048), _hi = *(const LAS u32x4*)(lds + G8_SB(b, h) + boff + n * 2048 + 16); \
        dst[n] = __builtin_shufflevector(__builtin_bit_cast(i32x4, _lo), __builtin_bit_cast(i32x4, _hi), 0, 1, 2, 3, 4, 5, 6, 7); } } while (0)
#define G8_MMA(ai, bj, At, Bt) do { __builtin_amdgcn_s_setprio(1); _Pragma("unroll") for (int m = 0; m < 4; ++m) _Pragma("unroll") for (int n = 0; n < 2; ++n) \
        asm volatile("v_mfma_scale_f32_16x16x128_f8f6f4 %0, %1, %2, %0, %3, %3 op_sel_hi:[0,0,0]" : "+v"(acc[ai][bj][m][n]) : "v"(Bt[n]), "v"(At[m]), "v"(scl)); __builtin_amdgcn_s_setprio(0); } while (0)
#define G8_WAIT_V(n) asm volatile("s_waitcnt vmcnt(" #n ")" ::: "memory")
#define G8_WAIT_L(n) asm volatile("s_waitcnt lgkmcnt(" #n ")" ::: "memory")
#define G8_BAR __builtin_amdgcn_s_barrier()
#define G8_SCHED __builtin_amdgcn_sched_barrier(0)
    Unit cur, nxt; int ui = 0;
    if (!S.next(0, cur)) return;
#pragma unroll
    for (int h = 0; h < 2; ++h)
#pragma unroll
        for (int i = 0; i < 2; ++i) vA[h][i] = GATHER ? S.aoff(cur, h, Rr[i], Cc[i]) : (unsigned)(Rr[i] * ROWB + Cc[i] * 2);
    f32x4 acc[2][2][4][2];
#pragma unroll
    for (int a = 0; a < 2; ++a)
#pragma unroll
        for (int b = 0; b < 2; ++b)
#pragma unroll
            for (int m = 0; m < 4; ++m)
#pragma unroll
                for (int n = 0; n < 2; ++n) acc[a][b][m][n] = (f32x4){0.f, 0.f, 0.f, 0.f};
    i32x8 At[4], B0[2], B1[2];
    const int scl = 0x7F7F7F7F;
#define G8_BIAS_DMA(unit, par) __builtin_amdgcn_global_load_lds((const unsigned*)(E.bias_ptr(unit, wid & 3) + lane), (LAS unsigned*)(lds + BTAB_OFF + (par) * 1024 + (wid & 3) * 256), 4, 0, 0)
    G8_BIAS_DMA(cur, 0);
    G8_STAGE(G8_SB(0, 0), cur.b0, voffB); G8_STAGE(G8_SA(0, 0), cur.a0, vA[0]); G8_STAGE(G8_SB(0, 1), (cur.b0 + Sched::B1OFF), voffB); G8_STAGE(G8_SA(0, 1), (cur.a0 + Sched::A1OFF), vA[1]);
    if (wr == 1) G8_BAR;
    G8_WAIT_V(4); G8_BAR;
    G8_STAGE(G8_SB(1, 0), cur.b0 + kstep, voffB); G8_STAGE(G8_SA(1, 0), cur.a0 + kstep, vA[0]); G8_STAGE(G8_SB(1, 1), (cur.b0 + Sched::B1OFF) + kstep, voffB);
    G8_WAIT_V(6); G8_BAR;
    for (;;) {
        const bool has_next = S.next(ui + 1, nxt);
        if (!has_next) nxt = cur;
            if (has_next) G8_BIAS_DMA(nxt, (ui + 1) % 3);
        if (GATHER && has_next)
            __builtin_amdgcn_global_load_lds((const unsigned*)(S.list_ptr(nxt) + (wid & 3) * 64 + lane), (LAS unsigned*)(lds + GTAB_OFF + (wid & 3) * 256), 4, 0, 0);
#pragma unroll 1
        for (int t = 0; t < nt; t += 2) {
            const bool last = (t == nt - 2);
            const char* a1h1 = (cur.a0 + Sched::A1OFF) + (size_t)(t + 1) * kstep;
            const char* a2h0 = last ? nxt.a0 : cur.a0 + (size_t)(t + 2) * kstep; const char* a2h1 = last ? (nxt.a0 + Sched::A1OFF) : (cur.a0 + Sched::A1OFF) + (size_t)(t + 2) * kstep;
            const char* b2h0 = last ? nxt.b0 : cur.b0 + (size_t)(t + 2) * kstep; const char* b2h1 = last ? (nxt.b0 + Sched::B1OFF) : (cur.b0 + Sched::B1OFF) + (size_t)(t + 2) * kstep;
            G8_LDB(B0, 0, 0); G8_SCHED; G8_LDA(At, 0, 0); G8_STAGE(G8_SA(1, 1), a1h1, vA[1]);
            if (GATHER && last && has_next) {
                const int lim = nxt.cm1 - nxt.m0;
#pragma unroll
                for (int h = 0; h < 2; ++h)
#pragma unroll
                    for (int i = 0; i < 2; ++i) { int ix = h * 128 + Rr[i]; ix = ix > lim ? lim : ix;
                        vA[h][i] = (unsigned)(*(const LAS int*)(lds + GTAB_OFF + ix * 4)) * (unsigned)ROWB + (unsigned)Cc[i] * 2u; }
            }
            G8_WAIT_L(8); G8_BAR; G8_WAIT_L(0); G8_MMA(0, 0, At, B0); G8_BAR; G8_SCHED;
            G8_LDB(B1, 0, 1); G8_STAGE(G8_SB(0, 0), b2h0, voffB);
            G8_BAR; G8_WAIT_L(0); G8_MMA(0, 1, At, B1); G8_BAR;
            G8_LDA(At, 0, 1); G8_STAGE(G8_SA(0, 0), a2h0, vA[0]);
            G8_BAR; G8_WAIT_L(0); G8_MMA(1, 0, At, B0); G8_BAR; G8_SCHED;
            G8_STAGE(G8_SB(0, 1), b2h1, voffB);
            G8_WAIT_V(6); G8_BAR; G8_MMA(1, 1, At, B1); G8_BAR;
            G8_LDB(B0, 1, 0); G8_SCHED; G8_LDA(At, 1, 0); G8_STAGE(G8_SA(0, 1), a2h1, vA[1]);
            G8_WAIT_L(8); G8_BAR; G8_WAIT_L(0); G8_MMA(0, 0, At, B0); G8_BAR; G8_SCHED;
            G8_LDB(B1, 1, 1); G8_STAGE(G8_SB(1, 0), b2h0 + kstep, voffB);
            G8_BAR; G8_WAIT_L(0); G8_MMA(0, 1, At, B1); G8_BAR;
            G8_LDA(At, 1, 1); G8_STAGE(G8_SA(1, 0), a2h0 + kstep, vA[0]);
            G8_BAR; G8_WAIT_L(0); G8_MMA(1, 0, At, B0); G8_BAR; G8_SCHED;
            G8_STAGE(G8_SB(1, 1), b2h1 + kstep, voffB);
            G8_WAIT_V(6); G8_BAR; G8_MMA(1, 1, At, B1); G8_BAR;
        }
        asm volatile("s_nop 15\n\ts_nop 15" ::: "memory");
        E(acc, cur, wr, wc, fr, fq, (const LAS float*)(lds + BTAB_OFF + (ui % 3) * 1024));
        if (!has_next) break;
#pragma unroll
        for (int a = 0; a < 2; ++a)
#pragma unroll
            for (int b = 0; b < 2; ++b)
#pragma unroll
                for (int m = 0; m < 4; ++m)
#pragma unroll
                    for (int n = 0; n < 2; ++n) acc[a][b][m][n] = (f32x4){0.f, 0.f, 0.f, 0.f};
        cur = nxt; ++ui;
    }
    G8_WAIT_V(0);
    if (wr == 0) G8_BAR;
    G8_BAR;
#undef G8_BIAS_DMA
#undef G8_SA
#undef G8_SB
#undef G8_STAGE
#undef G8_LDA
#undef G8_LDB
#undef G8_MMA
#undef G8_WAIT_V
#undef G8_WAIT_L
#undef G8_BAR
#undef G8_SCHED
}

struct DenseOrder {
    static constexpr size_t A1OFF = (size_t)128 * KB, B1OFF = (size_t)128 * KB;
    const char* A; const char* B; int nM, nN, nwg, G, c;
    __device__ __forceinline__ void init(const void* A_, const void* B_, int M, int N) { A = (const char*)A_; B = (const char*)B_; nM = M / 256; nN = N / 256; nwg = nM * nN; G = gridDim.x; c = blockIdx.x; }
    __device__ __forceinline__ bool next(int i, Unit& u) const {
        const int L = i * G + c; if (L >= nwg) return false;
        int wgid = L; { const int q = nwg / 8, r = nwg % 8, xcd = wgid % 8, off = wgid / 8; wgid = (xcd < r ? xcd * (q + 1) : r * (q + 1) + (xcd - r) * q) + off; }
        const int nig = 8 * nN, gid = wgid / nig, fm = gid * 8, gsz = (nM - fm) < 8 ? (nM - fm) : 8;
        const int pm = fm + ((wgid % nig) % gsz), pn = (wgid % nig) / gsz;
        u.a0 = A + (size_t)pm * 256 * KB; u.b0 = B + (size_t)pn * 256 * KB;
        u.r0 = pm * 256; u.c0 = pn * 256; u.e = 0; u.m0 = 0; u.cm1 = 0; return true;
    }
    __device__ __forceinline__ unsigned aoff(const Unit&, int, int, int) const { return 0u; }
    __device__ __forceinline__ const int* list_ptr(const Unit&) const { return nullptr; }
};
template <bool GATE_UP, int ROWB>
struct MoeOrder {
    const int* cnt; const int* list; const char* A; const char* W; int G, c; const LAS int* tab;
    static constexpr int NTN = GATE_UP ? 8 : 4;
    __device__ __forceinline__ void prepare(LAS int* t) {
        tab = t;
        if (threadIdx.x < 33) { int acc = 0; for (int e = 0; e < (int)threadIdx.x; ++e) acc += (cnt[e] + 255) >> 8; t[threadIdx.x] = acc; }
        else if (threadIdx.x >= 64 && threadIdx.x < 96) t[40 + threadIdx.x - 64] = cnt[threadIdx.x - 64];
        __syncthreads();
    }
    static constexpr size_t A1OFF = GATE_UP ? 0 : (size_t)128 * ROWB, B1OFF = GATE_UP ? (size_t)1024 * ROWB : (size_t)128 * ROWB;
    __device__ __forceinline__ const int* list_ptr(const Unit& u) const { return list + (size_t)u.e * NT + u.m0; }
    __device__ __forceinline__ bool next(int i, Unit& u) const {
        int tile, nt;
        if (G == 256) {
            const int x = c & 7, w = c >> 3;
            if (GATE_UP) { nt = (x & 1) * 4 + (w & 3); tile = i * 32 + (x >> 1) * 8 + (w >> 2); }
            else         { nt = w & 3;                 tile = i * 64 + x * 8 + (w >> 2); }
        } else { const int L = i * G + c; tile = L / NTN; nt = L % NTN; }
        const int ln = (int)(threadIdx.x & 31);
        const int ts = tab[ln], te = tab[ln + 1], cn = tab[40 + ln];
        const unsigned long long hit = __ballot(tile >= ts && tile < te);
        if (hit == 0ull) return false;
        const int fe = __builtin_amdgcn_readfirstlane(__builtin_ctzll(hit) & 31);
        const int fst = __builtin_amdgcn_readlane(ts, fe), fc = __builtin_amdgcn_readlane(cn, fe);
        const int fmt = tile - fst, fbase = fst * 256;
        u.e = fe; u.m0 = fmt * 256; u.cm1 = fc - 1; u.r0 = fbase + fmt * 256;
        if (GATE_UP) {
            u.a0 = A;
            u.b0 = W + ((size_t)fe * 2048 + (size_t)nt * 128) * ROWB; u.c0 = nt * 128;
        } else {
            u.a0 = A + (size_t)u.r0 * ROWB;
            u.b0 = W + ((size_t)fe * 1024 + (size_t)nt * 256) * ROWB; u.c0 = nt * 256;
        }
        return true;
    }
    __device__ __forceinline__ unsigned aoff(const Unit& u, int h, int R, int C) const {
        int i = u.m0 + h * 128 + R; i = i > u.cm1 ? u.cm1 : i;
        return (unsigned)list[(size_t)u.e * NT + i] * (unsigned)ROWB + (unsigned)C * 2u;
    }
};

struct EpiInproj {
    bf16_t* P; bf16_t* QB; bf16_t* KB; bf16_t* VT; const float* RC; const float* RS;
    __device__ __forceinline__ void operator()(const f32x4 (&acc)[2][2][4][2], const Unit& u, int wr, int wc, int fr, int fq) const {
        const int pn = u.c0 >> 8;
        if (pn >= 3) {
#pragma unroll
            for (int ai = 0; ai < 2; ++ai)
#pragma unroll
                for (int mp = 0; mp < 2; ++mp) {
                    bf16_t* rowp = P + (size_t)(u.r0 + ai * 128 + wr * 64 + (mp * 2 + (fq & 1)) * 16 + fr) * NP + u.c0 + wc * 32 + 4 * (fq & 2);
#pragma unroll
                    for (int bj = 0; bj < 2; ++bj)
#pragma unroll
                        for (int n = 0; n < 2; ++n) {
                            const f32x4 va = acc[ai][bj][mp * 2][n], vb = acc[ai][bj][mp * 2 + 1][n];
                            const auto r0 = __builtin_amdgcn_permlane16_swap(pack2bf(va[0], va[1]), pack2bf(vb[0], vb[1]), false, false);
                            const auto r1 = __builtin_amdgcn_permlane16_swap(pack2bf(va[2], va[3]), pack2bf(vb[2], vb[3]), false, false);
                            const u32x4 o = {r0[0], r1[0], r0[1], r1[1]};
                            *(u32x4*)(rowp + bj * 128 + n * 16) = o;
                        }
                }
            return;
        }
        const bool latent = u.r0 < NL;
#pragma unroll
        for (int ai = 0; ai < 2; ++ai)
#pragma unroll
            for (int mp = 0; mp < 2; ++mp) {
                uint2 W0[2][2], W1[2][2];
#pragma unroll
                for (int mi = 0; mi < 2; ++mi) {
                    const int m = mp * 2 + mi;
                    const int row = u.r0 + ai * 128 + wr * 64 + m * 16 + fr;
                    const int tok = row & (S - 1);
                    const int pos = (wc & 1) ? (tok & 63) : (tok >> 6);
                    f32x4 cs = (f32x4){1.f, 1.f, 1.f, 1.f}, sn = (f32x4){0.f, 0.f, 0.f, 0.f};
                    if (latent) { cs = *(const f32x4*)(RC + pos * 16 + 4 * fq); sn = *(const f32x4*)(RS + pos * 16 + 4 * fq); }
#pragma unroll
                    for (int bj = 0; bj < 2; ++bj) {
                        const f32x4 v0 = acc[ai][bj][m][0], v1 = acc[ai][bj][m][1];
                        if (pn == 2 && bj == 1) {
                            const int bb = latent ? (row >> 12) : ((row - NL) >> 8), tp = latent ? CTX + tok : ((row - NL) & (CTX - 1));
                            const int tq4 = fr & 3;
                            bf16_t* vt = VT + ((size_t)(bb * 2 + (wc >> 1)) * 64 + (wc & 1) * 32 + 4 * fq + tq4) * TPB + (tp - tq4);
                            const f32x4 y0 = quad_transpose(v0, tq4), y1 = quad_transpose(v1, tq4);
                            uint2 w0, w1; w0.x = pack2bf(y0[0], y0[1]); w0.y = pack2bf(y0[2], y0[3]); w1.x = pack2bf(y1[0], y1[1]); w1.y = pack2bf(y1[2], y1[3]);
                            *(uint2*)vt = w0; *(uint2*)(vt + (size_t)16 * TPB) = w1;
                            W0[bj][mi] = make_uint2(0u, 0u); W1[bj][mi] = make_uint2(0u, 0u);
                        } else {
                            const float sc = pn == 2 ? 1.f : 0.125f * 1.4426950408889634f;
                            const f32x4 o0 = (v0 * cs - v1 * sn) * sc, o1 = (v1 * cs + v0 * sn) * sc;
                            W0[bj][mi].x = pack2bf(o0[0], o0[1]); W0[bj][mi].y = pack2bf(o0[2], o0[3]); W1[bj][mi].x = pack2bf(o1[0], o1[1]); W1[bj][mi].y = pack2bf(o1[2], o1[3]);
                        }
                    }
                }
                const int rowS = u.r0 + ai * 128 + wr * 64 + (mp * 2 + (fq & 1)) * 16 + fr;
#pragma unroll
                for (int bj = 0; bj < 2; ++bj) {
                    if (pn == 2 && bj == 1) continue;
                    bf16_t* dst = pn == 2 ? KB + (size_t)rowS * 128 + wc * 32 + 4 * (fq & 2) : QB + (size_t)rowS * 512 + u.c0 + bj * 128 + wc * 32 + 4 * (fq & 2);
                    const auto a0 = __builtin_amdgcn_permlane16_swap(W0[bj][0].x, W0[bj][1].x, false, false), a1 = __builtin_amdgcn_permlane16_swap(W0[bj][0].y, W0[bj][1].y, false, false);
                    const auto b0 = __builtin_amdgcn_permlane16_swap(W1[bj][0].x, W1[bj][1].x, false, false), b1 = __builtin_amdgcn_permlane16_swap(W1[bj][0].y, W1[bj][1].y, false, false);
                    const u32x4 oa = {a0[0], a1[0], a0[1], a1[1]}, ob = {b0[0], b1[0], b0[1], b1[1]};
                    *(u32x4*)dst = oa; *(u32x4*)(dst + 16) = ob;
                }
            }
    }
};
struct EpiResid {
    float* X; const float* modl;
    __device__ __forceinline__ void operator()(const f32x4 (&acc)[2][2][4][2], const Unit& u, int wr, int wc, int fr, int fq) const {
        const float* g1 = modl + (size_t)mod_row(u.r0) * 6144 + u.c0 + wc * 32 + 4 * fq;
        f32x4 gv[2][2];
#pragma unroll
        for (int bj = 0; bj < 2; ++bj)
#pragma unroll
            for (int n = 0; n < 2; ++n) gv[bj][n] = *(const f32x4*)(g1 + bj * 128 + n * 16);
#pragma unroll
        for (int ai = 0; ai < 2; ++ai)
#pragma unroll
            for (int m = 0; m < 4; ++m) {
                float* rowp = X + (size_t)(u.r0 + ai * 128 + wr * 64 + m * 16 + fr) * 1024 + u.c0 + wc * 32 + 4 * fq;
#pragma unroll
                for (int bj = 0; bj < 2; ++bj)
#pragma unroll
                    for (int n = 0; n < 2; ++n) { f32x4* q = (f32x4*)(rowp + bj * 128 + n * 16); *q = *q + gv[bj][n] * acc[ai][bj][m][n]; }
                asm volatile("" ::: "memory");
            }
    }
};
struct EpiSwigluF8 {
    unsigned char* ACT; const float* bgl;
    __device__ __forceinline__ const float* bias_ptr(const Unit& u, int chunk) const { return bgl + (size_t)u.e * 2048 + u.c0 + (chunk >> 1) * 1024 + (chunk & 1) * 64; }
    __device__ __forceinline__ void operator()(const f32x4 (&acc)[2][2][4][2], const Unit& u, int wr, int wc, int fr, int fq, const LAS float* bl) const {
        asm volatile("" : "+v"(fr), "+v"(fq));
        f32x4 bgv[2], blv[2];
#pragma unroll
        for (int n = 0; n < 2; ++n) { bgv[n] = *(const LAS f32x4*)(bl + wc * 32 + 8 * fq + n * 4); blv[n] = *(const LAS f32x4*)(bl + 128 + wc * 32 + 8 * fq + n * 4); }
#pragma unroll
        for (int ai = 0; ai < 2; ++ai)
#pragma unroll
            for (int m = 0; m < 4; ++m) {
                unsigned char* rowp = ACT + (size_t)(u.r0 + ai * 128 + wr * 64 + m * 16 + fr) * 1024 + u.c0 + wc * 32 + 8 * fq;
                float a[8];
#pragma unroll
                for (int n = 0; n < 2; ++n) {
                    const f32x4 gl = acc[ai][0][m][n] * F8_OSCALE + bgv[n], li = acc[ai][1][m][n] * F8_OSCALE + blv[n];
#pragma unroll
                    for (int j = 0; j < 4; ++j) {
                        const float gq = fminf(gl[j], 7.f), lv = __builtin_amdgcn_fmed3f(li[j], -7.f, 7.f);
                        a[n * 4 + j] = (gq * __builtin_amdgcn_rcpf(1.f + __builtin_amdgcn_exp2f(gq * (-1.702f * 1.4426950408889634f)))) * (lv * F8_ASCALE + F8_ASCALE);
                    }
                }
                uint2 w; w.x = pack4fp8(a[0], a[1], a[2], a[3]); w.y = pack4fp8(a[4], a[5], a[6], a[7]);
                *(uint2*)rowp = w;
            }
    }
};
struct EpiBiasBf16 {
    unsigned char* Y; const float* bdl;
    __device__ __forceinline__ const float* bias_ptr(const Unit& u, int chunk) const { return bdl + (size_t)u.e * 1024 + u.c0 + chunk * 64; }
    __device__ __forceinline__ void operator()(const f32x4 (&acc)[2][2][4][2], const Unit& u, int wr, int wc, int fr, int fq, const LAS float* bl) const {
        f32x4 bv[2][2];
#pragma unroll
        for (int bj = 0; bj < 2; ++bj)
#pragma unroll
            for (int n = 0; n < 2; ++n) bv[bj][n] = *(const LAS f32x4*)(bl + bj * 128 + wc * 32 + 8 * fq + n * 4) * F8_YSCALE;
#pragma unroll
        for (int ai = 0; ai < 2; ++ai)
#pragma unroll
            for (int mp = 0; mp < 2; ++mp) {
                unsigned char* rowp = Y + (size_t)(u.r0 + ai * 128 + wr * 64 + (mp * 2 + (fq & 1)) * 16 + fr) * 1024 + u.c0 + wc * 32 + 8 * (fq & 2);
#pragma unroll
                for (int bj = 0; bj < 2; ++bj) {
                    uint2 w[2];
#pragma unroll
                    for (int mi = 0; mi < 2; ++mi) {
                        const f32x4 v0 = acc[ai][bj][mp * 2 + mi][0] * (F8_OSCALE * F8_YSCALE) + bv[bj][0], v1 = acc[ai][bj][mp * 2 + mi][1] * (F8_OSCALE * F8_YSCALE) + bv[bj][1];
                        w[mi].x = pack4fp8(v0[0], v0[1], v0[2], v0[3]); w[mi].y = pack4fp8(v1[0], v1[1], v1[2], v1[3]);
                    }
                    const auto r0 = __builtin_amdgcn_permlane16_swap(w[0].x, w[1].x, false, false), r1 = __builtin_amdgcn_permlane16_swap(w[0].y, w[1].y, false, false);
                    const u32x4 o = {r0[0], r1[0], r0[1], r1[1]};
                    *(u32x4*)(rowp + bj * 128) = o;
                }
            }
    }
};
}

__device__ __forceinline__ void transpose_tile(unsigned char* lds, const float* src, int ldn, int nvalid, bf16_t* dst, int k0, int n0) {
    float* T = (float*)lds;
    const int tid = threadIdx.x;
#pragma unroll
    for (int i = 0; i < 2; ++i) {
        const int r = (tid >> 4) + 32 * i, c4 = (tid & 15) * 4, n = n0 + c4;
        float4 v = make_float4(0.f, 0.f, 0.f, 0.f);
        if (n < nvalid) v = *(const float4*)(src + (size_t)(k0 + r) * ldn + n);
        T[r * 65 + c4 + 0] = v.x; T[r * 65 + c4 + 1] = v.y; T[r * 65 + c4 + 2] = v.z; T[r * 65 + c4 + 3] = v.w;
    }
    __syncthreads();
    {
        const int n = tid >> 3, kc = tid & 7;
        float v[8];
#pragma unroll
        for (int j = 0; j < 8; ++j) v[j] = T[(kc * 8 + j) * 65 + n];
        uint4 w; w.x = pack2bf(v[0], v[1]); w.y = pack2bf(v[2], v[3]); w.z = pack2bf(v[4], v[5]); w.w = pack2bf(v[6], v[7]);
        *(uint4*)(dst + (size_t)(n0 + n) * 1024 + k0 + kc * 8) = w;
    }
    __syncthreads();
}

__device__ __forceinline__ void transpose_tile_f8(unsigned char* lds, const float* src, int ldn, unsigned char* dst, int k0, int n0) {
    float* T = (float*)lds;
    const int tid = threadIdx.x;
#pragma unroll
    for (int i = 0; i < 2; ++i) {
        const int r = (tid >> 4) + 32 * i, c4 = (tid & 15) * 4;
        const float4 v = *(const float4*)(src + (size_t)(k0 + r) * ldn + n0 + c4);
        T[r * 65 + c4 + 0] = v.x; T[r * 65 + c4 + 1] = v.y; T[r * 65 + c4 + 2] = v.z; T[r * 65 + c4 + 3] = v.w;
    }
    __syncthreads();
    {
        const int n = tid >> 3, kc = tid & 7;
        float v[8];
#pragma unroll
        for (int j = 0; j < 8; ++j) v[j] = T[(kc * 8 + j) * 65 + n] * F8_WSCALE;
        uint2 w; w.x = pack4fp8(v[0], v[1], v[2], v[3]); w.y = pack4fp8(v[4], v[5], v[6], v[7]);
        *(uint2*)(dst + (size_t)(n0 + n) * 1024 + k0 + kc * 8) = w;
    }
    __syncthreads();
}

constexpr int CV_T0 = 16 * 34, CV_T1 = CV_T0 + 256, CV_T2 = CV_T1 + 32 * 512, CV_TT = CV_T2 + 32 * 256, CV_NPAIR = CV_TT / 2;
struct CvTile { const float* src; unsigned char* dst; int ldn, nv, k0, n0, kind; };
__device__ __forceinline__ CvTile cv_decode(const Params& p, int l, int it) {
    CvTile t;
    if (it < CV_T0) { const int r = it; t.k0 = (r / 34) * 64; t.n0 = (r % 34) * 64; t.src = p.in[I_WIN] + (size_t)l * 1024 * NINV; t.ldn = NINV; t.nv = NINV; t.dst = p.ws + WS_WIN + (size_t)l * NIN * 1024 * 2; t.kind = 0; }
    else if (it < CV_T1) { const int r = it - CV_T0; t.k0 = (r / 16) * 64; t.n0 = (r % 16) * 64; t.src = p.in[I_WOUT] + (size_t)l * 1024 * 1024; t.ldn = 1024; t.nv = 1024; t.dst = p.ws + WS_WOUT + (size_t)l * 1024 * 1024 * 2; t.kind = 0; }
    else if (it < CV_T2) { const int i2 = it - CV_T1, le = l * 32 + i2 / 512, r = i2 % 512; t.k0 = (r % 16) * 64; t.n0 = (r / 16) * 64; t.src = p.in[I_WGU] + (size_t)le * 1024 * 2048; t.ldn = 2048; t.nv = 2048; t.dst = p.ws + WS_WGU + (size_t)le * 2048 * 1024; t.kind = 1; }
    else { const int i2 = it - CV_T2, le = l * 32 + i2 / 256, r = i2 % 256; t.k0 = (r % 16) * 64; t.n0 = (r / 16) * 64; t.src = p.in[I_WDN] + (size_t)le * 1024 * 1024; t.ldn = 1024; t.nv = 1024; t.dst = p.ws + WS_WDN + (size_t)le * 1024 * 1024; t.kind = 1; }
    return t;
}
__device__ __forceinline__ void convert_pairs(const Params& p, unsigned char* lds, int l, int q_first, int q_stride, int q_end) {
    constexpr int D = 4;
    const int tid = threadIdx.x;
    float* T = (float*)lds;
    const int npair = (q_first < q_end) ? (q_end - q_first + q_stride - 1) / q_stride : 0, ntile = 2 * npair;
    const int lr = tid >> 4, lc4 = (tid & 15) * 4;
    float4 pv[D][2];
    __syncthreads();
#pragma unroll
    for (int d = 0; d < D; ++d) {
#pragma unroll
        for (int i = 0; i < 2; ++i) pv[d][i] = make_float4(0.f, 0.f, 0.f, 0.f);
        if (d < ntile) {
            const CvTile t = cv_decode(p, l, 2 * (q_first + (d >> 1) * q_stride) + (d & 1));
#pragma unroll
            for (int i = 0; i < 2; ++i) if (t.n0 + lc4 < t.nv) pv[d][i] = *(const float4*)(t.src + (size_t)(t.k0 + lr + 32 * i) * t.ldn + t.n0 + lc4);
        }
    }
#pragma unroll 1
    for (int s0 = 0; s0 < ntile; s0 += D) {
#pragma unroll
        for (int d = 0; d < D; ++d) {
            const int s = s0 + d;
            if (s < ntile) {
                float* Tp = T + (d & 1) * 64 * 65;
#pragma unroll
                for (int i = 0; i < 2; ++i) { float* q = Tp + (lr + 32 * i) * 65 + lc4; q[0] = pv[d][i].x; q[1] = pv[d][i].y; q[2] = pv[d][i].z; q[3] = pv[d][i].w; }
                __syncthreads();
                if (s + D < ntile) {
                    const int s2 = s + D;
                    const CvTile t = cv_decode(p, l, 2 * (q_first + (s2 >> 1) * q_stride) + (s2 & 1));
#pragma unroll
                    for (int i = 0; i < 2; ++i) { pv[d][i] = make_float4(0.f, 0.f, 0.f, 0.f); if (t.n0 + lc4 < t.nv) pv[d][i] = *(const float4*)(t.src + (size_t)(t.k0 + lr + 32 * i) * t.ldn + t.n0 + lc4); }
                }
                const CvTile c = cv_decode(p, l, 2 * (q_first + (s >> 1) * q_stride) + (s & 1));
                const int n = tid >> 3, kc = tid & 7;
                float v[8];
#pragma unroll
                for (int j = 0; j < 8; ++j) v[j] = Tp[(kc * 8 + j) * 65 + n];
                if (c.kind == 0) {
                    uint4 w; w.x = pack2bf(v[0], v[1]); w.y = pack2bf(v[2], v[3]); w.z = pack2bf(v[4], v[5]); w.w = pack2bf(v[6], v[7]);
                    *(uint4*)(c.dst + ((size_t)(c.n0 + n) * 1024 + c.k0 + kc * 8) * 2) = w;
                } else {
                    uint2 w; w.x = pack4fp8(v[0] * F8_WSCALE, v[1] * F8_WSCALE, v[2] * F8_WSCALE, v[3] * F8_WSCALE); w.y = pack4fp8(v[4] * F8_WSCALE, v[5] * F8_WSCALE, v[6] * F8_WSCALE, v[7] * F8_WSCALE);
                    *(uint2*)(c.dst + (size_t)(c.n0 + n) * 1024 + c.k0 + kc * 8) = w;
                }
            }
        }
    }
    __syncthreads();
}
constexpr int CV_Q0 = 1920, CV_Q1 = CV_Q0 + 2912, CV_Q2 = CV_Q1 + 3584;
__device__ __forceinline__ void convert_tail(const Params& p, unsigned char* lds, int slot, int nunits) {
    const int G = gridDim.x, c = blockIdx.x, first = nunits % G;
    if (c < first) return;
    const int lo = (slot == 0) ? 0 : (slot == 1) ? CV_Q0 : (slot == 2) ? CV_Q1 : CV_Q2, hi = (slot == 0) ? CV_Q0 : (slot == 1) ? CV_Q1 : (slot == 2) ? CV_Q2 : CV_NPAIR;
    convert_pairs(p, lds, 1, lo + (c - first), G - first, hi);
}


__device__ __forceinline__ void ph_setup(const Params& p, unsigned char* lds) {
    const int tid = threadIdx.x, G = gridDim.x, bid = blockIdx.x;
    if (bid == 0) {
        int* cnt = (int*)(p.ws + WS_CNT);
        if (tid < 64) cnt[tid] = 0;
        float* rc = (float*)(p.ws + WS_ROPE);
        for (int i = tid; i < 1024; i += NTHR) {
            const int pos = i >> 4, f = i & 15;
            double th = 1.0;
            for (int q = 0; q < f; ++q) th *= 0.56234132519034908;
            const double t2 = th * th;
            double c1 = 1.0, s1 = th, tc = 1.0, tsn = th;
            for (int q = 1; q <= 12; ++q) {
                tc *= -t2 / (double)((2 * q - 1) * (2 * q));
                tsn *= -t2 / (double)((2 * q) * (2 * q + 1));
                c1 += tc; s1 += tsn;
            }
            double cc = 1.0, ss = 0.0;
            for (int q = 0; q < pos; ++q) { const double nc = cc * c1 - ss * s1, ns = ss * c1 + cc * s1; cc = nc; ss = ns; }
            rc[i] = (float)cc; rc[1024 + i] = (float)ss;
        }
    }
    for (int idx = bid * NTHR + tid; idx < 2 * 32 * 1024; idx += G * NTHR) {
        const int l = idx >> 15, e = (idx >> 10) & 31, k = idx & 1023;
        const float w = p.in[I_WR][((size_t)l * 1024 + k) * 32 + e];
        const unsigned short hi = f2bf(w), lo = f2bf(w - bf2f(hi));
        bf16_t* WRT = (bf16_t*)(p.ws + WS_WRT) + (size_t)l * 2 * 32 * 1024;
        WRT[e * 1024 + k] = hi; WRT[32 * 1024 + e * 1024 + k] = lo;
    }
    {
        float* sil = (float*)lds;
        float* part = sil + 9 * 1024;
        float* MOD = (float*)(p.ws + WS_MOD);
        const int wid = tid >> 6, lane = tid & 63;
        for (int it = bid; it < 192; it += G) {
            const int l = it / 96, j0 = (it % 96) * 64;
            for (int idx = tid; idx < 9 * 1024; idx += NTHR) {
                const int r = idx >> 10, k = idx & 1023;
                const float v = r < 8 ? p.in[I_C][r * 1024 + k] : p.in[I_CCTX][k];
                sil[idx] = silu_f(v);
            }
            __syncthreads();
            float acc[9];
#pragma unroll
            for (int r = 0; r < 9; ++r) acc[r] = 0.f;
            const float* w = p.in[I_WADA] + (size_t)l * 1024 * 6144 + j0 + lane;
#pragma unroll 1
            for (int k0 = wid * 128; k0 < wid * 128 + 128; k0 += 16) {
                float wv[16];
#pragma unroll
                for (int u = 0; u < 16; ++u) wv[u] = w[(size_t)(k0 + u) * 6144];
#pragma unroll
                for (int u = 0; u < 16; ++u)
#pragma unroll
                    for (int r = 0; r < 9; ++r) acc[r] += sil[r * 1024 + k0 + u] * wv[u];
            }
#pragma unroll
            for (int r = 0; r < 9; ++r) part[(wid * 9 + r) * 64 + lane] = acc[r];
            __syncthreads();
            for (int idx = tid; idx < 9 * 64; idx += NTHR) {
                const int r = idx >> 6, c = idx & 63;
                float s = 0.f;
#pragma unroll
                for (int w8 = 0; w8 < 8; ++w8) s += part[(w8 * 9 + r) * 64 + c];
                MOD[(size_t)(l * 9 + r) * 6144 + j0 + c] = s + p.in[I_BADA][l * 6144 + j0 + c];
            }
            __syncthreads();
        }
    }
    convert_pairs(p, lds, 0, bid, G, CV_NPAIR);
}

__device__ __forceinline__ int expert_rowbase(const int* cnt, int e) {
    int base = 0;
    for (int q = 0; q < e; ++q) base += ((cnt[q] + 255) >> 8) << 8;
    return base;
}

__device__ __forceinline__ void ph_prep1(const Params& p, int l) {
    const int tid = threadIdx.x, lane = tid & 63, gw = blockIdx.x * NWAVE + (tid >> 6), GW = gridDim.x * NWAVE;
    float* XW = (float*)(p.ws + WS_XW);
    bf16_t* H = (bf16_t*)(p.ws + WS_H);
    const float* MOD = (const float*)(p.ws + WS_MOD);
    const float* nw = p.in[I_NMIX] + l * 1024;
    int mybase = 0;
    if (l == 1) mybase = expert_rowbase((const int*)(p.ws + WS_CNT), lane & 31);
    if (blockIdx.x == gridDim.x - 1) {
        for (int idx = tid; idx < 9 * 32; idx += NTHR) {
            const int bb = idx >> 5, e = idx & 31;
            const float* sh2 = MOD + (size_t)(l * 9 + bb) * 6144 + 3072;
            const float* wr = p.in[I_WR] + (size_t)l * 1024 * 32 + e;
            float s = 0.f;
            for (int k = 0; k < 1024; ++k) s += sh2[k] * wr[(size_t)k * 32];
            ((float*)(p.ws + WS_C9))[(l * 9 + bb) * 32 + e] = s + p.in[I_BR][l * 32 + e];
        }
    }
    for (int row = gw; row < NT; row += GW) {
        const int mr = mod_row(row);
        float4 xv[4];
        if (l == 0) {
            const float* src = row < NL ? p.in[I_X] + (size_t)row * 1024 : p.in[I_CTX] + (size_t)(row - NL) * 1024;
#pragma unroll
            for (int j = 0; j < 4; ++j) xv[j] = *(const float4*)(src + j * 256 + lane * 4);
        } else {
#pragma unroll
            for (int j = 0; j < 4; ++j) xv[j] = *(const float4*)(XW + (size_t)row * 1024 + j * 256 + lane * 4);
            const int* route = (const int*)(p.ws + WS_ROUTE) + row * 4;
            const float* gate = (const float*)(p.ws + WS_GATE) + row * 4;
            const unsigned char* Y = p.ws + WS_Y;
            const float* g2 = MOD + (size_t)(0 * 9 + mr) * 6144 + 5120;
            float4 fs[4];
#pragma unroll
            for (int j = 0; j < 4; ++j) fs[j] = make_float4(0.f, 0.f, 0.f, 0.f);
#pragma unroll
            for (int k = 0; k < 4; ++k) {
                const int rt = route[k]; const float gk = gate[k] * (1.f / F8_YSCALE);
                const int e = rt >> 16, slot = rt & 0xffff;
                const int pos = __shfl(mybase, e) + slot;
                const unsigned char* yr = Y + (size_t)pos * 1024;
#pragma unroll
                for (int j = 0; j < 4; ++j) {
                    const unsigned w = *(const unsigned*)(yr + j * 256 + lane * 4);
                    const auto lo2 = __builtin_amdgcn_cvt_pk_f32_fp8(w, false), hi2 = __builtin_amdgcn_cvt_pk_f32_fp8(w, true);
                    fs[j].x += gk * lo2[0]; fs[j].y += gk * lo2[1]; fs[j].z += gk * hi2[0]; fs[j].w += gk * hi2[1];
                }
            }
#pragma unroll
            for (int j = 0; j < 4; ++j) {
                const float4 g = *(const float4*)(g2 + j * 256 + lane * 4);
                xv[j].x += g.x * fs[j].x; xv[j].y += g.y * fs[j].y; xv[j].z += g.z * fs[j].z; xv[j].w += g.w * fs[j].w;
            }
        }
#pragma unroll
        for (int j = 0; j < 4; ++j) *(float4*)(XW + (size_t)row * 1024 + j * 256 + lane * 4) = xv[j];
        float ss = 0.f;
#pragma unroll
        for (int j = 0; j < 4; ++j) ss += xv[j].x * xv[j].x + xv[j].y * xv[j].y + xv[j].z * xv[j].z + xv[j].w * xv[j].w;
        ss = wave_sum(ss);
        const float rstd = rsqrtf(ss * (1.f / 1024.f) + EPS);
        const float* sh = MOD + (size_t)(l * 9 + mr) * 6144;
        const float* sc = sh + 1024;
#pragma unroll
        for (int j = 0; j < 4; ++j) {
            const int k = j * 256 + lane * 4;
            const float4 w = *(const float4*)(nw + k), a = *(const float4*)(sc + k), b = *(const float4*)(sh + k);
            const float h0 = xv[j].x * rstd * w.x * (1.f + a.x) + b.x, h1 = xv[j].y * rstd * w.y * (1.f + a.y) + b.y;
            const float h2 = xv[j].z * rstd * w.z * (1.f + a.z) + b.z, h3 = xv[j].w * rstd * w.w * (1.f + a.w) + b.w;
            uint2 o; o.x = pack2bf(h0, h1); o.y = pack2bf(h2, h3);
            *(uint2*)(H + (size_t)row * 1024 + k) = o;
        }
    }
}

__device__ __forceinline__ void ph_inproj(const Params& p, int l, unsigned char* lds) {
    g8::DenseOrder S; S.init(p.ws + WS_H, p.ws + WS_WIN + (size_t)l * NIN * 1024 * 2, NT, NP);
    g8::EpiInproj E{(bf16_t*)(p.ws + WS_P), (bf16_t*)(p.ws + WS_QB), (bf16_t*)(p.ws + WS_KB), (bf16_t*)(p.ws + WS_VT), (const float*)(p.ws + WS_ROPE), (const float*)(p.ws + WS_ROPE) + 1024};
    g8::gemm_phase<false, false>((LAS unsigned char*)lds, S, E);
    if (l == 0) convert_tail(p, lds, 0, (NT / 256) * (NP / 256));
}

__device__ __forceinline__ void attn_item(const Params& p, int l, unsigned char* lds, int b, int g, int t0, bool isctx) {
    const int tid = threadIdx.x, wid = tid >> 6, lane = tid & 63, fr = lane & 15, fq = lane >> 4;
    bf16_t* Ksm = (bf16_t*)lds;
    bf16_t* VT = Ksm + 64 * 72;
    const int hh = wid >> 1, th = wid & 1, head = g * 4 + hh;
    const int tokb = t0 + th * 32;
    const bf16_t* QB = (const bf16_t*)(p.ws + WS_QB);
    const bf16_t* KBg = (const bf16_t*)(p.ws + WS_KB);
    const bf16_t* VTg = (const bf16_t*)(p.ws + WS_VT) + (size_t)(b * 2 + g) * 64 * TPB;
    bf16x8 qf[2][2];
#pragma unroll
    for (int m = 0; m < 2; ++m) {
        const int tq = tokb + m * 16 + fr;
        const int qrow = isctx ? NL + b * CTX + tq : b * S + tq;
#pragma unroll
        for (int ks = 0; ks < 2; ++ks) qf[m][ks] = *(const bf16x8*)(QB + (size_t)qrow * 512 + head * 64 + ks * 32 + fq * 8);
    }
    float mrun[2], lrun[2];
    f32x4 oacc[2][4];
    {
        const float sink = p.in[I_SINK][l * 8 + head] * 1.4426950408889634f;
#pragma unroll
        for (int m = 0; m < 2; ++m) {
            mrun[m] = sink; lrun[m] = 1.f;
#pragma unroll
            for (int dt = 0; dt < 4; ++dt) oacc[m][dt] = (f32x4){0.f, 0.f, 0.f, 0.f};
        }
    }
    int wstart = 0, wend = 0;
    if (!isctx) { wstart = t0 - 128 < 0 ? 0 : t0 - 128; wend = t0 + 64 + 128 > S ? S : t0 + 64 + 128; }
    const int ntile = 4 + ((wend - wstart) >> 6);
    const int kk = tid >> 3, dq = tid & 7;
    uint4 kreg, vreg;
    auto tile_key0 = [&](int t) { return t < 4 ? t * 64 : wstart + (t - 4) * 64; };
#define ATT_LOAD(t) do { const int _k0 = tile_key0(t); const int _krow = ((t) < 4 ? NL + b * CTX + _k0 : b * S + _k0) + kk; const int _tp = ((t) < 4 ? _k0 : CTX + _k0) + dq * 8; \
        kreg = *(const uint4*)(KBg + (size_t)_krow * 128 + g * 64 + dq * 8); vreg = *(const uint4*)(VTg + (size_t)kk * TPB + _tp); } while (0)
    ATT_LOAD(0);
#pragma unroll 1
    for (int t = 0; t < ntile; ++t) {
        const bool cx = t < 4;
        const int tk0 = tile_key0(t);
        __syncthreads();
        *(uint4*)(Ksm + kk * 72 + dq * 8) = kreg;
        *(uint4*)(VT + kk * 72 + dq * 8) = vreg;
        __syncthreads();
        if (t + 1 < ntile) ATT_LOAD(t + 1);
        f32x4 sacc[2][4];
#pragma unroll
        for (int nt = 0; nt < 4; ++nt) {
            const bf16x8 k0 = *(const bf16x8*)(Ksm + (nt * 16 + fr) * 72 + fq * 8), k1 = *(const bf16x8*)(Ksm + (nt * 16 + fr) * 72 + 32 + fq * 8);
#pragma unroll
            for (int m = 0; m < 2; ++m) {
                f32x4 a = (f32x4){0.f, 0.f, 0.f, 0.f};
                a = __builtin_amdgcn_mfma_f32_16x16x32_bf16(k0, qf[m][0], a, 0, 0, 0);
                a = __builtin_amdgcn_mfma_f32_16x16x32_bf16(k1, qf[m][1], a, 0, 0, 0);
                sacc[m][nt] = a;
            }
        }
        const bool need_mask = !cx && (tk0 < t0 - 65 || tk0 > t0 + 65);
        bf16x8 pb[2][2];
#pragma unroll
        for (int m = 0; m < 2; ++m) {
            const int tq = tokb + m * 16 + fr;
            float mx = -1e30f;
            if (need_mask) {
#pragma unroll
                for (int nt = 0; nt < 4; ++nt)
#pragma unroll
                    for (int r = 0; r < 4; ++r) {
                        const int dlt = tq - (tk0 + nt * 16 + 4 * fq + r);
                        sacc[m][nt][r] = (dlt <= 128 && dlt >= -128) ? sacc[m][nt][r] : -1e30f;
                    }
            }
#pragma unroll
            for (int nt = 0; nt < 4; ++nt)
#pragma unroll
                for (int r = 0; r < 4; ++r) mx = fmaxf(mx, sacc[m][nt][r]);
            mx = fmaxf(mx, __shfl_xor(mx, 16)); mx = fmaxf(mx, __shfl_xor(mx, 32));
            const float mn = fmaxf(mrun[m], mx);
            const float corr = __builtin_amdgcn_exp2f(mrun[m] - mn);
            float rs = 0.f;
#pragma unroll
            for (int nt = 0; nt < 4; ++nt)
#pragma unroll
                for (int r = 0; r < 4; ++r) { const float pe = __builtin_amdgcn_exp2f(sacc[m][nt][r] - mn); sacc[m][nt][r] = pe; rs += pe; }
            rs += __shfl_xor(rs, 16); rs += __shfl_xor(rs, 32);
            lrun[m] = lrun[m] * corr + rs; mrun[m] = mn;
#pragma unroll
            for (int dt = 0; dt < 4; ++dt) oacc[m][dt] *= corr;
#pragma unroll
            for (int ks = 0; ks < 2; ++ks) {
                pb[m][ks] = pack8bf(sacc[m][2 * ks][0], sacc[m][2 * ks][1], sacc[m][2 * ks][2], sacc[m][2 * ks][3], sacc[m][2 * ks + 1][0], sacc[m][2 * ks + 1][1], sacc[m][2 * ks + 1][2], sacc[m][2 * ks + 1][3]);
            }
        }
#pragma unroll
        for (int ks = 0; ks < 2; ++ks)
#pragma unroll
            for (int dt = 0; dt < 4; ++dt) {
                const uint2 vlo = *(const uint2*)(VT + (dt * 16 + fr) * 72 + ks * 32 + 4 * fq), vhi = *(const uint2*)(VT + (dt * 16 + fr) * 72 + ks * 32 + 16 + 4 * fq);
                const u32x4 vw = (u32x4){vlo.x, vlo.y, vhi.x, vhi.y};
                const bf16x8 vf = __builtin_bit_cast(bf16x8, vw);
#pragma unroll
                for (int m = 0; m < 2; ++m) oacc[m][dt] = __builtin_amdgcn_mfma_f32_16x16x32_bf16(vf, pb[m][ks], oacc[m][dt], 0, 0, 0);
            }
    }
#undef ATT_LOAD
    float* ATT = (float*)(p.ws + WS_ATT);
#pragma unroll
    for (int m = 0; m < 2; ++m) {
        const int tq = tokb + m * 16 + fr;
        const int qrow = isctx ? NL + b * CTX + tq : b * S + tq;
        const float inv = 1.f / lrun[m];
        float* dst = ATT + (size_t)qrow * 512 + head * 64 + 4 * fq;
#pragma unroll
        for (int dt = 0; dt < 4; ++dt) *(f32x4*)(dst + dt * 16) = oacc[m][dt] * inv;
    }
    __syncthreads();
}

__device__ __forceinline__ float softplus_f(float x) { return fmaxf(x, 0.f) + log1pf(expf(-fabsf(x))); }
__device__ __forceinline__ int ssd_row0(int b, int blk) { return blk < 2 ? NL + b * CTX + blk * 128 : b * S + (blk - 2) * 128; }
__device__ __forceinline__ void ssd_cs(const float* dtraw, int col, float bias, float a, int d, int lane, float& cs0, float& cs1, float& dt0, float& dt1, float& total) {
    dt0 = softplus_f(dtraw[(2 * lane) * 16 + col] + bias); dt1 = softplus_f(dtraw[(2 * lane + 1) * 16 + col] + bias);
    const float la0 = dt0 * a, la1 = dt1 * a;
    float incl = la0 + la1;
#pragma unroll
    for (int o = 1; o < 64; o <<= 1) { const float t = __shfl_up(incl, o); if (lane >= o) incl += t; }
    total = __shfl(incl, 63);
    const float p1 = incl, p0 = incl - la1;
    if (d == 0) { cs0 = p0; cs1 = p1; } else { cs0 = total - p0 + la0; cs1 = total - p1 + la1; }
}

__device__ __forceinline__ void ssd1_item(const Params& p, int l, unsigned char* lds, int it) {
    const int tid = threadIdx.x, wid = tid >> 6, lane = tid & 63, fr = lane & 15, fq = lane >> 4;
    const int b = it / 68, rr = it % 68, blk = rr >> 1, g = rr & 1;
    const bool isctx = blk < 2;
    const int row0 = ssd_row0(b, blk);
    const int s0 = isctx ? NL + b * CTX : b * S, s1 = s0 + (isctx ? CTX : S);
    bf16_t* XT = (bf16_t*)lds;
    bf16_t* BT = XT + 256 * 136;
    float* dtraw = (float*)(BT + 64 * 136);
    float* wgt = dtraw + 128 * 16;
    bf16_t* CT = (bf16_t*)(wgt + 8 * 128);
    const bf16_t* P = (const bf16_t*)(p.ws + WS_P);
    __syncthreads();
    {
        const bf16_t* A = (const bf16_t*)(p.ws + WS_H) + (size_t)(row0 + wid * 16 + fr) * 1024 + fq * 8;
        const bf16_t* Bw = (const bf16_t*)(p.ws + WS_WIN) + ((size_t)l * NIN + 2048 + fr) * 1024 + fq * 8;
        f32x4 acc = (f32x4){0.f, 0.f, 0.f, 0.f};
#pragma unroll 8
        for (int k = 0; k < 32; ++k) {
            const bf16x8 av = *(const bf16x8*)(A + k * 32), bv = *(const bf16x8*)(Bw + k * 32);
            acc = __builtin_amdgcn_mfma_f32_16x16x32_bf16(av, bv, acc, 0, 0, 0);
        }
        float* DT = (float*)(p.ws + WS_DT + (size_t)l * DT_STRIDE);
#pragma unroll
        for (int j = 0; j < 4; ++j) {
            dtraw[(wid * 16 + fq * 4 + j) * 16 + fr] = acc[j];
            if (g == 0) DT[(size_t)(row0 + wid * 16 + fq * 4 + j) * 16 + fr] = acc[j];
        }
    }
    {
        bf16_t* UXT = (bf16_t*)(p.ws + WS_UXT) + (size_t)it * 256 * 128;
#pragma unroll 1
        for (int k = 0; k < 3; ++k) {
            const int u = tid + NTHR * k, cc = u % 384, tq = u / 384;
            const int col = cc < 256 ? g * 256 + cc : (cc < 320 ? 512 + g * 64 + (cc - 256) : 640 + g * 64 + (cc - 320));
            float cw[5];
#pragma unroll
            for (int w = 0; w < 5; ++w) cw[w] = p.in[I_CONVW][(l * 5 + w) * 768 + col];
            const float cb = p.in[I_CONVB][l * 768 + col];
            const unsigned* src = (const unsigned*)(P + OXBC + (col & ~1));
            const int csh = (col & 1) * 16;
            unsigned raw[36];
#pragma unroll
            for (int i = 0; i < 36; ++i) {
                const int rw = row0 + tq * 32 - 2 + i;
                raw[i] = (rw >= s0 && rw < s1) ? src[(size_t)rw * (NP / 2)] : 0u;
            }
            __builtin_amdgcn_sched_barrier(0);
            float v[36];
#pragma unroll
            for (int i = 0; i < 36; ++i) v[i] = __uint_as_float((raw[i] >> csh) << 16);
#pragma unroll
            for (int ch = 0; ch < 4; ++ch) {
                const int t0 = tq * 32 + ch * 8;
                float o[8];
#pragma unroll
                for (int i = 0; i < 8; ++i) { const int q = ch * 8 + i; o[i] = silu_f(cb + v[q] * cw[0] + v[q + 1] * cw[1] + v[q + 2] * cw[2] + v[q + 3] * cw[3] + v[q + 4] * cw[4]); }
                uint4 w; w.x = pack2bf(o[0], o[1]); w.y = pack2bf(o[2], o[3]); w.z = pack2bf(o[4], o[5]); w.w = pack2bf(o[6], o[7]);
                if (cc < 256) {
                    *(uint4*)(XT + cc * 136 + t0) = w;
                    *(uint4*)(UXT + (size_t)cc * 128 + t0) = w;
                } else if (cc < 320) {
                    *(uint4*)(BT + (cc - 256) * 136 + t0) = w;
                } else {
                    *(uint4*)(CT + (cc - 320) * 136 + t0) = w;
                }
            }
        }
    }
    __syncthreads();
    {
        bf16_t* UBN = (bf16_t*)(p.ws + WS_UBN) + (size_t)it * 128 * 64;
        bf16_t* UCN = (bf16_t*)(p.ws + WS_UCN) + (size_t)it * 128 * 64;
#pragma unroll
        for (int i = 0; i < 4; ++i) {
            const int id = wid * 4 + i, which = id >> 4, s = id & 15, c = lane >> 3, t = (8 * c + (lane & 7) + 8 * s) & 127;
            const bf16_t* sp = (which ? CT : BT) + (c * 8) * 136 + t;
            u32x4 w;
#pragma unroll
            for (int k = 0; k < 4; ++k) w[k] = (unsigned)sp[(2 * k) * 136] | ((unsigned)sp[(2 * k + 1) * 136] << 16);
            *(u32x4*)((which ? UCN : UBN) + (size_t)t * 64 + c * 8) = w;
        }
    }
    const int h = wid >> 1, d = wid & 1, hg = g * 4 + h;
    const size_t sidx = ((size_t)(b * 8 + hg) * 2 + d) * NBLK + blk;
    {
        const float a = -expf(p.in[I_ALOG][l * 16 + d * 8 + hg]);
        const float bias = p.in[I_DTB][l * 16 + d * 8 + hg];
        float cs0, cs1, dt0, dt1, total;
        ssd_cs(dtraw, d * 8 + hg, bias, a, d, lane, cs0, cs1, dt0, dt1, total);
        wgt[wid * 128 + 2 * lane] = expf(total - cs0) * dt0;
        wgt[wid * 128 + 2 * lane + 1] = expf(total - cs1) * dt1;
        if (lane == 0) st_wt((float*)(p.ws + WS_DEC + (size_t)l * DEC_STRIDE) + sidx, expf(total));
    }
    f32x4 acc[4][4];
#pragma unroll
    for (int pt = 0; pt < 4; ++pt)
#pragma unroll
        for (int nt = 0; nt < 4; ++nt) acc[pt][nt] = (f32x4){0.f, 0.f, 0.f, 0.f};
#pragma unroll 1
    for (int ks = 0; ks < 4; ++ks) {
        const float4 wa = *(const float4*)(wgt + wid * 128 + ks * 32 + fq * 8), wb = *(const float4*)(wgt + wid * 128 + ks * 32 + fq * 8 + 4);
        const float wv[8] = {wa.x, wa.y, wa.z, wa.w, wb.x, wb.y, wb.z, wb.w};
        bf16x8 bfr[4];
#pragma unroll
        for (int nt = 0; nt < 4; ++nt) bfr[nt] = *(const bf16x8*)(BT + (nt * 16 + fr) * 136 + ks * 32 + fq * 8);
#pragma unroll
        for (int pt = 0; pt < 4; ++pt) {
            const bf16x8 xa = *(const bf16x8*)(XT + (h * 64 + pt * 16 + fr) * 136 + ks * 32 + fq * 8);
            const bf16x8 xs = pack8bf(bf2f((unsigned short)xa[0]) * wv[0], bf2f((unsigned short)xa[1]) * wv[1], bf2f((unsigned short)xa[2]) * wv[2], bf2f((unsigned short)xa[3]) * wv[3],
                                      bf2f((unsigned short)xa[4]) * wv[4], bf2f((unsigned short)xa[5]) * wv[5], bf2f((unsigned short)xa[6]) * wv[6], bf2f((unsigned short)xa[7]) * wv[7]);
#pragma unroll
            for (int nt = 0; nt < 4; ++nt) acc[pt][nt] = __builtin_amdgcn_mfma_f32_16x16x32_bf16(xs, bfr[nt], acc[pt][nt], 0, 0, 0);
        }
    }
    float* ST = (float*)(p.ws + WS_ST) + sidx * 4096 + (fq * 4) * 64 + fr;
#pragma unroll
    for (int pt = 0; pt < 4; ++pt) {
#pragma unroll
        for (int nt = 0; nt < 4; ++nt)
#pragma unroll
            for (int j = 0; j < 4; ++j) ST[(pt * 16 + j) * 64 + nt * 16] = acc[pt][nt][j];
        __builtin_amdgcn_sched_barrier(0);
    }
}

__device__ __forceinline__ void ph_attn_ssd1(const Params& p, int l, unsigned char* lds, int mask = 3) {
    const int n_lat = NBATCH * 2 * (S / 64);
    const int n_ctx = (l == 0) ? NBATCH * 2 * (CTX / 64) : 0;
    const int first = (mask & 1) ? 0 : NITEM, lastx = (mask & 2) ? NITEM + n_lat + n_ctx : NITEM;
    for (int it = first + blockIdx.x; it < lastx; it += gridDim.x) {
        if (it < NITEM) {
            ssd1_item(p, l, lds, it);
        } else if (it < NITEM + n_lat) {
            const int i2 = it - NITEM, b = i2 / 128, r = i2 % 128, g = r / 64, t0 = (r % 64) * 64;
            attn_item(p, l, lds, b, g, t0, false);
        } else {
            const int i2 = it - NITEM - n_lat, b = i2 / 8, r = i2 % 8, g = r / 4, t0 = (r % 4) * 64;
            attn_item(p, l, lds, b, g, t0, true);
        }
    }
}

__device__ __forceinline__ void ph_ssd2(const Params& p, int l) {
    const float* ST = (const float*)(p.ws + WS_ST);
    const float* DEC = (const float*)(p.ws + WS_DEC + (size_t)l * DEC_STRIDE);
    bf16_t* HS = (bf16_t*)(p.ws + WS_HS);
    for (int idx = blockIdx.x * NTHR + threadIdx.x; idx < 128 * 1024; idx += gridDim.x * NTHR) {
        const int seq = idx >> 10, e4 = (idx & 1023) * 4, d = seq & 1;
        const float* stb = ST + (size_t)seq * NBLK * 4096 + e4;
        const float* dcb = DEC + (size_t)seq * NBLK;
        bf16_t* hsb = HS + (size_t)seq * NBLK * 4096 + e4;
        float4 hst = make_float4(0.f, 0.f, 0.f, 0.f);
#pragma unroll 1
        for (int half = 0; half < 2; ++half) {
            float4 sv[17]; float dc[17];
#pragma unroll
            for (int c = 0; c < 17; ++c) {
                const int cc = half * 17 + c;
                const int blk = d == 0 ? cc : (cc < 2 ? 1 - cc : 35 - cc);
                sv[c] = *(const float4*)(stb + (size_t)blk * 4096); dc[c] = dcb[blk];
            }
#pragma unroll
            for (int c = 0; c < 17; ++c) {
                const int cc = half * 17 + c;
                const int blk = d == 0 ? cc : (cc < 2 ? 1 - cc : 35 - cc);
                uint2 w; w.x = pack2bf(hst.x, hst.y); w.y = pack2bf(hst.z, hst.w);
                *(uint2*)(hsb + (size_t)blk * 4096) = w;
                hst.x = dc[c] * hst.x + sv[c].x; hst.y = dc[c] * hst.y + sv[c].y; hst.z = dc[c] * hst.z + sv[c].z; hst.w = dc[c] * hst.w + sv[c].w;
            }
        }
    }
}

__device__ __forceinline__ void ssd3_item(const Params& p, int l, unsigned char* lds, int it) {
    const int tid = threadIdx.x, wid = tid >> 6, lane = tid & 63, fr = lane & 15, fq = lane >> 4;
    const int b = it / 68, rr = it % 68, blk = rr >> 1, g = rr & 1;
    const int row0 = ssd_row0(b, blk);
    bf16_t* XT = (bf16_t*)lds;
    bf16_t* Cn = XT + 256 * 136;
    bf16_t* Bn = Cn + 128 * 72;
    bf16_t* Mst = Bn + 128 * 72;
    float* dtraw = (float*)Mst;
    float* csA = (float*)(Mst + 8 * 16 * 136);
    float* dtA = csA + 8 * 128;
    float* ssq = dtA + 8 * 128;
    __syncthreads();
    {
        const bf16_t* UXT = (const bf16_t*)(p.ws + WS_UXT) + (size_t)it * 256 * 128;
        const bf16_t* UBN = (const bf16_t*)(p.ws + WS_UBN) + (size_t)it * 128 * 64;
        const bf16_t* UCN = (const bf16_t*)(p.ws + WS_UCN) + (size_t)it * 128 * 64;
#pragma unroll
        for (int k = 0; k < 8; ++k) { const int c = tid + NTHR * k, row = c >> 4, tc = c & 15; *(uint4*)(XT + row * 136 + tc * 8) = *(const uint4*)(UXT + (size_t)row * 128 + tc * 8); }
#pragma unroll
        for (int k = 0; k < 2; ++k) {
            const int c = tid + NTHR * k, row = c >> 3, nc = c & 7;
            *(uint4*)(Cn + row * 72 + nc * 8) = *(const uint4*)(UCN + (size_t)row * 64 + nc * 8);
            *(uint4*)(Bn + row * 72 + nc * 8) = *(const uint4*)(UBN + (size_t)row * 64 + nc * 8);
        }
        *(float4*)(dtraw + tid * 4) = *(const float4*)((const float*)(p.ws + WS_DT + (size_t)l * DT_STRIDE) + (size_t)row0 * 16 + tid * 4);
    }
    __syncthreads();
    {
        const int h = wid >> 1, d = wid & 1, hg = g * 4 + h;
        const float a = -expf(p.in[I_ALOG][l * 16 + d * 8 + hg]);
        const float bias = p.in[I_DTB][l * 16 + d * 8 + hg];
        float cs0, cs1, dt0, dt1, total;
        ssd_cs(dtraw, d * 8 + hg, bias, a, d, lane, cs0, cs1, dt0, dt1, total);
        csA[wid * 128 + 2 * lane] = cs0; csA[wid * 128 + 2 * lane + 1] = cs1;
        dtA[wid * 128 + 2 * lane] = dt0; dtA[wid * 128 + 2 * lane + 1] = dt1;
    }
    __syncthreads();
    const int h = wid >> 1, rh = wid & 1, hg = g * 4 + h;
    bf16_t* Mw = Mst + wid * 16 * 136;
    const float dsk = p.in[I_DSKIP][l * 8 + hg];
    const bf16_t* P = (const bf16_t*)(p.ws + WS_P);
    bf16_t* MIX = (bf16_t*)(p.ws + WS_MIX);
    const float* nw = p.in[I_SSMNW] + l * 512 + hg * 64;
#pragma unroll 1
    for (int st = 0; st < 4; ++st) {
        const int i0 = rh * 64 + st * 16;
        f32x4 y[4];
#pragma unroll
        for (int pt = 0; pt < 4; ++pt) y[pt] = (f32x4){0.f, 0.f, 0.f, 0.f};
        bf16x8 cf[2];
#pragma unroll
        for (int ks = 0; ks < 2; ++ks) cf[ks] = *(const bf16x8*)(Cn + (i0 + fr) * 72 + ks * 32 + fq * 8);
#pragma unroll 1
        for (int d = 0; d < 2; ++d) {
            const float* cs = csA + (h * 2 + d) * 128;
            const float* dtv = dtA + (h * 2 + d) * 128;
            const bf16_t* HS = (const bf16_t*)(p.ws + WS_HS) + (((size_t)(b * 8 + hg) * 2 + d) * NBLK + blk) * 4096;
            bf16x8 hf[4][2];
#pragma unroll
            for (int pt = 0; pt < 4; ++pt)
#pragma unroll
                for (int ks = 0; ks < 2; ++ks) hf[pt][ks] = *(const bf16x8*)(HS + (pt * 16 + fr) * 64 + ks * 32 + fq * 8);
            float csi[4];
#pragma unroll
            for (int r = 0; r < 4; ++r) csi[r] = cs[i0 + 4 * fq + r];
#pragma unroll 1
            for (int jt = 0; jt < 8; ++jt) {
                const bool need = d == 0 ? (jt * 16 <= i0 + 15) : (jt * 16 + 15 >= i0);
                f32x4 gacc = (f32x4){0.f, 0.f, 0.f, 0.f};
                const int j = jt * 16 + fr;
                if (need) {
#pragma unroll
                    for (int ks = 0; ks < 2; ++ks) {
                        const bf16x8 bfv = *(const bf16x8*)(Bn + (jt * 16 + fr) * 72 + ks * 32 + fq * 8);
                        gacc = __builtin_amdgcn_mfma_f32_16x16x32_bf16(cf[ks], bfv, gacc, 0, 0, 0);
                    }
                    const float csj = cs[j], dtj = dtv[j];
#pragma unroll
                    for (int r = 0; r < 4; ++r) {
                        const int i = i0 + 4 * fq + r;
                        const bool ok = d == 0 ? (j <= i) : (j >= i);
                        gacc[r] = ok ? gacc[r] * __expf(csi[r] - csj) * dtj : 0.f;
                    }
                }
#pragma unroll
                for (int r = 0; r < 4; ++r) Mw[(4 * fq + r) * 136 + j] = f2bf(gacc[r]);
            }
#pragma unroll 1
            for (int k4 = 0; k4 < 4; ++k4) {
                const bool need = d == 0 ? (k4 * 32 <= i0 + 15) : (k4 * 32 + 31 >= i0);
                if (need) {
                    const bf16x8 mf = *(const bf16x8*)(Mw + fr * 136 + k4 * 32 + fq * 8);
#pragma unroll
                    for (int pt = 0; pt < 4; ++pt) {
                        const bf16x8 xf = *(const bf16x8*)(XT + (h * 64 + pt * 16 + fr) * 136 + k4 * 32 + fq * 8);
                        y[pt] = __builtin_amdgcn_mfma_f32_16x16x32_bf16(mf, xf, y[pt], 0, 0, 0);
                    }
                }
            }
#pragma unroll
            for (int pt = 0; pt < 4; ++pt) {
                f32x4 a2 = (f32x4){0.f, 0.f, 0.f, 0.f};
#pragma unroll
                for (int ks = 0; ks < 2; ++ks) a2 = __builtin_amdgcn_mfma_f32_16x16x32_bf16(cf[ks], hf[pt][ks], a2, 0, 0, 0);
#pragma unroll
                for (int r = 0; r < 4; ++r) y[pt][r] += __expf(csi[r]) * a2[r];
            }
        }
        float sq[4] = {0.f, 0.f, 0.f, 0.f};
#pragma unroll
        for (int pt = 0; pt < 4; ++pt)
#pragma unroll
            for (int r = 0; r < 4; ++r) {
                const int i = i0 + 4 * fq + r, pch = pt * 16 + fr;
                const float xv = bf2f(XT[(h * 64 + pch) * 136 + i]);
                const float z = bf2f(P[(size_t)(row0 + i) * NP + OZ + hg * 64 + pch]);
                const float gv = (y[pt][r] + dsk * xv) * silu_f(z);
                y[pt][r] = gv; sq[r] += gv * gv;
            }
#pragma unroll
        for (int r = 0; r < 4; ++r) {
            float s = sq[r];
            s += __shfl_xor(s, 1); s += __shfl_xor(s, 2); s += __shfl_xor(s, 4); s += __shfl_xor(s, 8);
            if (fr == 0) ssq[(i0 + 4 * fq + r) * 4 + h] = s;
        }
        __syncthreads();
#pragma unroll
        for (int r = 0; r < 4; ++r) {
            const int i = i0 + 4 * fq + r;
            const float4 s4 = *(const float4*)(ssq + i * 4);
            const float rstd = rsqrtf((s4.x + s4.y + s4.z + s4.w) * (1.f / 256.f) + EPS);
#pragma unroll
            for (int pt = 0; pt < 4; ++pt) {
                const int pch = pt * 16 + fr;
                MIX[(size_t)(row0 + i) * 1024 + 512 + hg * 64 + pch] = f2bf(y[pt][r] * rstd * nw[pch]);
            }
        }
    }
}

__device__ __forceinline__ void ph_ssd3_prepout(const Params& p, int l, unsigned char* lds) {
    const int nitem = (l == 0) ? NITEM : NITEM;
    for (int it = blockIdx.x; it < nitem; it += gridDim.x) ssd3_item(p, l, lds, it);
    if (l == 0) convert_tail(p, lds, 1, NITEM);
    const int rfirst = nitem % (int)gridDim.x;
    if ((int)blockIdx.x < rfirst) return;
    const int tid = threadIdx.x, lane = tid & 63, gw = ((int)blockIdx.x - rfirst) * NWAVE + (tid >> 6), GW = ((int)gridDim.x - rfirst) * NWAVE;
    const float* ATT = (const float*)(p.ws + WS_ATT);
    bf16_t* MIX = (bf16_t*)(p.ws + WS_MIX);
    const int nrows = (l == 0) ? NT : NL;
    for (int row = gw; row < nrows; row += GW) {
        float4 av[2];
        float ss = 0.f;
#pragma unroll
        for (int j = 0; j < 2; ++j) {
            av[j] = *(const float4*)(ATT + (size_t)row * 512 + j * 256 + lane * 4);
            ss += av[j].x * av[j].x + av[j].y * av[j].y + av[j].z * av[j].z + av[j].w * av[j].w;
        }
        ss = wave_sum(ss);
        const float rstd = rsqrtf(ss * (1.f / 512.f) + EPS);
#pragma unroll
        for (int j = 0; j < 2; ++j) {
            const int k = j * 256 + lane * 4;
            const float4 w = *(const float4*)(p.in[I_ATTNW] + l * 512 + k);
            uint2 o; o.x = pack2bf(av[j].x * rstd * w.x, av[j].y * rstd * w.y); o.y = pack2bf(av[j].z * rstd * w.z, av[j].w * rstd * w.w);
            *(uint2*)(MIX + (size_t)row * 1024 + k) = o;
        }
    }
}

__device__ __forceinline__ void ph_outproj(const Params& p, int l, unsigned char* lds) {
    g8::DenseOrder S; S.init(p.ws + WS_MIX, p.ws + WS_WOUT + (size_t)l * 1024 * 1024 * 2, (l == 0) ? NT : NL, 1024);
    g8::EpiResid E{(float*)(p.ws + WS_XW), (const float*)(p.ws + WS_MOD) + (size_t)l * 9 * 6144 + 2048};
    g8::gemm_phase<false, false>((LAS unsigned char*)lds, S, E);
    if (l == 0) convert_tail(p, lds, 2, (NT / 256) * 4);
}

template <bool DRY>
__device__ __forceinline__ void ph_prep2(const Params& p, int l, unsigned char* lds) {
    const int tid = threadIdx.x, wid = tid >> 6, lane = tid & 63, fr = lane & 15, fq = lane >> 4;
    const float* XW = (const float*)(p.ws + WS_XW);
    unsigned char* H8 = p.ws + (DRY ? WS_MIX : WS_H);
    const float* MOD = (const float*)(p.ws + WS_MOD);
    const float* nw = p.in[I_NFFN] + l * 1024;
    const bf16_t* WH = (const bf16_t*)(p.ws + WS_WRT) + (size_t)l * 2 * 32 * 1024;
    const bf16_t* WL = WH + 32 * 1024;
    int* cnt = (int*)(p.ws + WS_CNT) + l * 32;
    int* list = (int*)(p.ws + WS_LIST + (size_t)l * LIST_STRIDE);
    int* route = (int*)(p.ws + WS_ROUTE + (size_t)l * RG_STRIDE);
    float* gate = (float*)(p.ws + WS_GATE + (size_t)l * RG_STRIDE);
    float* wl = (float*)lds + wid * 16 * 33;
    int* hist = (int*)((float*)lds + 8 * 16 * 33);
    int* basee = hist + 32;
    const int nitems = ((l == 0) ? NT : NL) / 128;
    for (int it = blockIdx.x; it < nitems; it += gridDim.x) {
        const int r0 = it * 128 + wid * 16, mr = mod_row(r0);
        const float* sh = MOD + (size_t)(l * 9 + mr) * 6144 + 3072;
        const float* sc = sh + 1024;
        if (tid < 32) hist[tid] = 0;
        f32x4 acc[2] = {(f32x4){0.f, 0.f, 0.f, 0.f}, (f32x4){0.f, 0.f, 0.f, 0.f}};
        const float* xrow = XW + (size_t)(r0 + fr) * 1024 + fq * 8;
        float ss = 0.f;
#pragma unroll 4
        for (int ks = 0; ks < 32; ++ks) {
            const int k = ks * 32 + fq * 8;
            const float4 x0 = *(const float4*)(xrow + ks * 32), x1 = *(const float4*)(xrow + ks * 32 + 4);
            const float4 w0 = *(const float4*)(nw + k), w1 = *(const float4*)(nw + k + 4), s0 = *(const float4*)(sc + k), s1 = *(const float4*)(sc + k + 4);
            ss += x0.x * x0.x + x0.y * x0.y + x0.z * x0.z + x0.w * x0.w + x1.x * x1.x + x1.y * x1.y + x1.z * x1.z + x1.w * x1.w;
            const float xa[8] = {x0.x * w0.x * (1.f + s0.x), x0.y * w0.y * (1.f + s0.y), x0.z * w0.z * (1.f + s0.z), x0.w * w0.w * (1.f + s0.w),
                                 x1.x * w1.x * (1.f + s1.x), x1.y * w1.y * (1.f + s1.y), x1.z * w1.z * (1.f + s1.z), x1.w * w1.w * (1.f + s1.w)};
            const bf16x8 ahi = pack8bf(xa[0], xa[1], xa[2], xa[3], xa[4], xa[5], xa[6], xa[7]);
            const bf16x8 alo = pack8bf(xa[0] - bf2f((unsigned short)ahi[0]), xa[1] - bf2f((unsigned short)ahi[1]), xa[2] - bf2f((unsigned short)ahi[2]), xa[3] - bf2f((unsigned short)ahi[3]),
                                       xa[4] - bf2f((unsigned short)ahi[4]), xa[5] - bf2f((unsigned short)ahi[5]), xa[6] - bf2f((unsigned short)ahi[6]), xa[7] - bf2f((unsigned short)ahi[7]));
#pragma unroll
            for (int nt = 0; nt < 2; ++nt) {
                const bf16x8 bh = *(const bf16x8*)(WH + (size_t)(nt * 16 + fr) * 1024 + k), bl = *(const bf16x8*)(WL + (size_t)(nt * 16 + fr) * 1024 + k);
                acc[nt] = __builtin_amdgcn_mfma_f32_16x16x32_bf16(ahi, bh, acc[nt], 0, 0, 0);
                acc[nt] = __builtin_amdgcn_mfma_f32_16x16x32_bf16(ahi, bl, acc[nt], 0, 0, 0);
                acc[nt] = __builtin_amdgcn_mfma_f32_16x16x32_bf16(alo, bh, acc[nt], 0, 0, 0);
            }
        }
        ss += __shfl_xor(ss, 16); ss += __shfl_xor(ss, 32);
        const float my_rstd = rsqrtf(ss * (1.f / 1024.f) + EPS);
#pragma unroll 4
        for (int rr = 0; rr < 16; ++rr) {
            const float* xr = XW + (size_t)(r0 + rr) * 1024;
            const float rstd = __shfl(my_rstd, rr);
#pragma unroll
            for (int j = 0; j < 4; ++j) {
                const int k = j * 256 + lane * 4;
                const float4 xv = *(const float4*)(xr + k);
                const float4 w = *(const float4*)(nw + k), a = *(const float4*)(sc + k), b4 = *(const float4*)(sh + k);
                const unsigned o = pack4fp8((xv.x * rstd * w.x * (1.f + a.x) + b4.x) * F8_ASCALE, (xv.y * rstd * w.y * (1.f + a.y) + b4.y) * F8_ASCALE,
                                            (xv.z * rstd * w.z * (1.f + a.z) + b4.z) * F8_ASCALE, (xv.w * rstd * w.w * (1.f + a.w) + b4.w) * F8_ASCALE);
                *(unsigned*)(H8 + (size_t)(r0 + rr) * 1024 + k) = o;
            }
        }
        {
            const float* c9 = (const float*)(p.ws + WS_C9) + (l * 9 + mr) * 32;
#pragma unroll
            for (int r = 0; r < 4; ++r) {
                const float rs = __shfl(my_rstd, 4 * fq + r);
#pragma unroll
                for (int nt = 0; nt < 2; ++nt) wl[(4 * fq + r) * 33 + nt * 16 + fr] = acc[nt][r] * rs + c9[nt * 16 + fr];
            }
        }
        const int rrow = lane >> 2, kk = lane & 3;
        float lg[32];
#pragma unroll
        for (int e2 = 0; e2 < 32; ++e2) lg[e2] = wl[rrow * 33 + e2];
        unsigned taken = 0u;
        float tv[4]; int ti[4];
#pragma unroll
        for (int k = 0; k < 4; ++k) {
            float best = -3.0e38f; int bi = 0;
#pragma unroll
            for (int e2 = 0; e2 < 32; ++e2) {
                const bool ok = !((taken >> e2) & 1u) && lg[e2] > best;
                best = ok ? lg[e2] : best; bi = ok ? e2 : bi;
            }
            taken |= 1u << bi; tv[k] = best; ti[k] = bi;
        }
        const float e1 = __expf(tv[1] - tv[0]), e2v = __expf(tv[2] - tv[0]), e3 = __expf(tv[3] - tv[0]);
        const float inv = 1.f / (1.f + e1 + e2v + e3);
        const int ek = kk == 0 ? ti[0] : kk == 1 ? ti[1] : kk == 2 ? ti[2] : ti[3];
        const float gk = (kk == 0 ? 1.f : kk == 1 ? e1 : kk == 2 ? e2v : e3) * inv;
        if (DRY) { asm volatile("" :: "v"(gk), "v"(ek)); continue; }
        __syncthreads();
        const int rank = atomicAdd(&hist[ek], 1);
        __syncthreads();
        if (tid < 32) { const int hc = hist[tid]; basee[tid] = hc ? atomicAdd(&cnt[tid], hc) : 0; }
        __syncthreads();
        const int slot = basee[ek] + rank, row = r0 + rrow;
        st_wt(list + (size_t)ek * NT + slot, row);
        route[row * 4 + kk] = (ek << 16) | slot;
        gate[row * 4 + kk] = gk;
        __syncthreads();
    }
    if (!DRY && l == 0) convert_tail(p, lds, 3, nitems);
}

__device__ __forceinline__ void ph_moe1(const Params& p, int l, unsigned char* lds) {
    g8::MoeOrder<true, 1024> S{(const int*)(p.ws + WS_CNT) + l * 32, (const int*)(p.ws + WS_LIST + (size_t)l * LIST_STRIDE), (const char*)(p.ws + WS_H),
                               (const char*)(p.ws + WS_WGU) + (size_t)l * 32 * 2048 * 1024, (int)gridDim.x, (int)blockIdx.x, nullptr};
    S.prepare((LAS int*)((LAS unsigned char*)lds + g8::MTAB_OFF));
    g8::EpiSwigluF8 E{p.ws + WS_ACT, p.in[I_BGU] + (size_t)l * 32 * 2048};
    g8::gemm_phase_f8<true, true>((LAS unsigned char*)lds, S, E);
}
__device__ __forceinline__ void ph_moe2(const Params& p, int l, unsigned char* lds) {
    g8::MoeOrder<false, 1024> S{(const int*)(p.ws + WS_CNT) + l * 32, (const int*)(p.ws + WS_LIST + (size_t)l * LIST_STRIDE), (const char*)(p.ws + WS_ACT),
                                (const char*)(p.ws + WS_WDN) + (size_t)l * 32 * 1024 * 1024, (int)gridDim.x, (int)blockIdx.x, nullptr};
    S.prepare((LAS int*)((LAS unsigned char*)lds + g8::MTAB_OFF));
    g8::EpiBiasBf16 E{p.ws + WS_Y, p.in[I_BDN] + (size_t)l * 32 * 1024};
    g8::gemm_phase_f8<false, true>((LAS unsigned char*)lds, S, E);
}

__device__ __forceinline__ void ph_final(const Params& p) {
    const int tid = threadIdx.x, lane = tid & 63, gw = blockIdx.x * NWAVE + (tid >> 6), GW = gridDim.x * NWAVE;
    const float* XW = (const float*)(p.ws + WS_XW);
    const float* MOD = (const float*)(p.ws + WS_MOD);
    const unsigned char* Y = p.ws + WS_Y;
    const int mybase = expert_rowbase((const int*)(p.ws + WS_CNT) + 32, lane & 31);
    for (int row = gw; row < NL; row += GW) {
        const int mr = mod_row(row);
        const int* route = (const int*)(p.ws + WS_ROUTE + RG_STRIDE) + row * 4;
        const float* gate = (const float*)(p.ws + WS_GATE + RG_STRIDE) + row * 4;
        const float* g2 = MOD + (size_t)(1 * 9 + mr) * 6144 + 5120;
        float4 xv[4], fs[4];
#pragma unroll
        for (int j = 0; j < 4; ++j) { xv[j] = *(const float4*)(XW + (size_t)row * 1024 + j * 256 + lane * 4); fs[j] = make_float4(0.f, 0.f, 0.f, 0.f); }
#pragma unroll
        for (int k = 0; k < 4; ++k) {
            const int rt = route[k]; const float gk = gate[k] * (1.f / F8_YSCALE);
            const int e = rt >> 16, slot = rt & 0xffff;
            const int pos = __shfl(mybase, e) + slot;
            const unsigned char* yr = Y + (size_t)pos * 1024;
#pragma unroll
            for (int j = 0; j < 4; ++j) {
                const unsigned w = *(const unsigned*)(yr + j * 256 + lane * 4);
                const auto lo2 = __builtin_amdgcn_cvt_pk_f32_fp8(w, false), hi2 = __builtin_amdgcn_cvt_pk_f32_fp8(w, true);
                fs[j].x += gk * lo2[0]; fs[j].y += gk * lo2[1]; fs[j].z += gk * hi2[0]; fs[j].w += gk * hi2[1];
            }
        }
        float ss = 0.f;
#pragma unroll
        for (int j = 0; j < 4; ++j) {
            const float4 g = *(const float4*)(g2 + j * 256 + lane * 4);
            xv[j].x += g.x * fs[j].x; xv[j].y += g.y * fs[j].y; xv[j].z += g.z * fs[j].z; xv[j].w += g.w * fs[j].w;
            ss += xv[j].x * xv[j].x + xv[j].y * xv[j].y + xv[j].z * xv[j].z + xv[j].w * xv[j].w;
        }
        ss = wave_sum(ss);
        const float rstd = rsqrtf(ss * (1.f / 1024.f) + EPS);
#pragma unroll
        for (int j = 0; j < 4; ++j) {
            const int k = j * 256 + lane * 4;
            const float4 w = *(const float4*)(p.in[I_FNW] + k);
            *(float4*)(p.out + (size_t)row * 1024 + k) = make_float4(xv[j].x * rstd * w.x, xv[j].y * rstd * w.y, xv[j].z * rstd * w.z, xv[j].w * rstd * w.w);
        }
    }
}

#define XB_TMO      128
#define XB_XCNT(j)  (256  + 64 * (j))
#define XB_XSUB(j)  (1280 + 64 * (j))
#define XB_XGEN(j)  (2304 + 64 * (j))
#define XB_TOP      3328
#define XB_TOPGEN   3392
#define XCD_BAR_WORDS 3456
#define XB_SPIN_CAP (1u << 18)
__device__ __forceinline__ unsigned xb_ld(unsigned* p)              { return __hip_atomic_load(p, __ATOMIC_RELAXED, __HIP_MEMORY_SCOPE_AGENT); }
__device__ __forceinline__ unsigned xb_add(unsigned* p, unsigned v) { return __hip_atomic_fetch_add(p, v, __ATOMIC_RELAXED, __HIP_MEMORY_SCOPE_AGENT); }
__device__ __forceinline__ unsigned xb_xcc_id() { return (unsigned)__builtin_amdgcn_s_getreg((3 << 11) | 20) & 0xFu; }
#define XB_SPIN(cond, bar) do { unsigned _sp = 0; while (cond) { __builtin_amdgcn_s_sleep(1); \
    if ((++_sp & 255u) == 0u) { if (xb_ld(&(bar)[XB_TMO])) break; if (_sp > XB_SPIN_CAP) { atomicAdd(&(bar)[XB_TMO], 1u); break; } } } } while (0)
struct XcdBarrier { unsigned* bar; unsigned x; volatile LAS unsigned* st; };
__device__ __forceinline__ XcdBarrier xcd_barrier_post(unsigned* bar, volatile LAS unsigned* st) {
    XcdBarrier b; b.bar = bar; b.x = xb_xcc_id(); b.st = st;
    if (threadIdx.x == 0) (void)xb_add(&bar[XB_XCNT(b.x)], 1u);
    return b;
}
__device__ __forceinline__ void xcd_barrier_complete(unsigned* bar, unsigned x, unsigned& nloc, unsigned& nx) {
    const unsigned G = gridDim.x * gridDim.y * gridDim.z;
    unsigned sum, cnt, mine, sp = 0u;
    for (;;) {
        sum = 0u; cnt = 0u; mine = 0u;
#pragma unroll
        for (unsigned j = 0; j < 16; ++j) { const unsigned c = xb_ld(&bar[XB_XCNT(j)]); sum += c; cnt += (c > 0u) ? 1u : 0u; mine = (j == x) ? c : mine; }
        if (sum == G) break;
        __builtin_amdgcn_s_sleep(1);
        if ((++sp & 255u) == 0u) { if (xb_ld(&bar[XB_TMO])) break; if (sp > XB_SPIN_CAP) { atomicAdd(&bar[XB_TMO], 1u); break; } }
    }
    nloc = mine > 0u ? mine : 1u; nx = cnt > 0u ? cnt : 1u;
}
__device__ __forceinline__ void xcd_barrier(const XcdBarrier& b) {
    asm volatile("s_waitcnt vmcnt(0)" ::: "memory");
    __syncthreads();
    if (threadIdx.x == 0) {
        unsigned* bar = b.bar;
        __builtin_amdgcn_s_waitcnt(0);
        unsigned nloc = b.st[0], nx = b.st[1];
        if (nloc == 0u) { xcd_barrier_complete(bar, b.x, nloc, nx); b.st[0] = nloc; b.st[1] = nx; }
        const unsigned old = xb_add(&bar[XB_XSUB(b.x)], 1u);
        const unsigned gen = old / nloc;
        if (old + 1u == (gen + 1u) * nloc) {
            __builtin_amdgcn_fence(__ATOMIC_RELEASE, "agent");
            asm volatile("s_waitcnt vmcnt(0)" ::: "memory");
            const unsigned og = xb_add(&bar[XB_TOP], 1u);
            const unsigned tg = og / nx;
            if (og + 1u == (tg + 1u) * nx) xb_add(&bar[XB_TOPGEN], 1u);
            else XB_SPIN(xb_ld(&bar[XB_TOPGEN]) == tg, bar);
            __builtin_amdgcn_fence(__ATOMIC_ACQUIRE, "agent");
            xb_add(&bar[XB_XGEN(b.x)], 1u);
            asm volatile("s_waitcnt vmcnt(0)" ::: "memory");
        } else {
            XB_SPIN(xb_ld(&bar[XB_XGEN(b.x)]) == gen, bar);
            __builtin_amdgcn_fence(__ATOMIC_ACQUIRE, "agent");
            asm volatile("s_waitcnt vmcnt(0)" ::: "memory");
        }
    }
    __syncthreads();
}

#ifndef PROBE_KIND
#define PROBE_KIND 0
#endif
namespace g8 {
struct EpiNone {
    __device__ __forceinline__ void operator()(const f32x4 (&acc)[2][2][4][2], const Unit&, int, int, int, int) const {
#pragma unroll
        for (int ai = 0; ai < 2; ++ai)
#pragma unroll
            for (int m = 0; m < 4; ++m) asm volatile("" :: "v"(acc[ai][0][m][0]), "v"(acc[ai][0][m][1]), "v"(acc[ai][1][m][0]), "v"(acc[ai][1][m][1]));
    }
};
}
__device__ __forceinline__ void ph_probe(const Params& p, unsigned char* lds, const XcdBarrier* xb) {
#if PROBE_KIND == 8
    for (int i = 0; i < 10; ++i) xcd_barrier(*xb);
#elif PROBE_KIND == 6
    ph_attn_ssd1(p, 0, lds, 2);
#elif PROBE_KIND == 7
    ph_attn_ssd1(p, 0, lds, 1);
#elif PROBE_KIND == 4
    ph_prep2<true>(p, 0, lds);
#elif PROBE_KIND == 5
    { g8::DenseOrder S; S.init(p.ws + WS_MIX, p.ws + WS_WOUT, NT, 1024); g8::EpiNone E; g8::gemm_phase<false, false>((LAS unsigned char*)lds, S, E); }
#endif
}

constexpr int N_PHASES = 20;
__global__ void __launch_bounds__(NTHR, 2) fwd(Params p) {
    extern __shared__ __attribute__((aligned(16))) unsigned char lds[];
    const int lo = p.ph_lo, hi = p.ph_hi;
    volatile LAS unsigned* xbst = (volatile LAS unsigned*)((LAS unsigned char*)lds + LDS_BYTES - 16);
    if (threadIdx.x < 4) xbst[threadIdx.x] = 0u;
    __syncthreads();
    const XcdBarrier xbar = xcd_barrier_post((unsigned*)(p.ws + WS_CTL), xbst);
#ifndef DUP_PHASE
#define DUP_PHASE -1
#endif
    if (lo == 0x7fffffff) cg::this_grid().sync();
#define PH(k, call) if (lo <= (k) && (k) < hi) { if ((k) > lo) xcd_barrier(xbar); call; if ((k) == DUP_PHASE) { call; } if (PROBE_KIND != 0 && (k) == (PROBE_KIND >= 6 ? 3 : 7)) { xcd_barrier(xbar); ph_probe(p, lds, &xbar); } }
    PH(0, ph_setup(p, lds))
    PH(1, ph_prep1(p, 0))
    PH(2, ph_inproj(p, 0, lds))
    PH(3, ph_attn_ssd1(p, 0, lds))
    PH(4, ph_ssd2(p, 0))
    PH(5, ph_ssd3_prepout(p, 0, lds))
    PH(6, ph_outproj(p, 0, lds))
    PH(7, ph_prep2<false>(p, 0, lds))
    PH(8, ph_moe1(p, 0, lds))
    PH(9, ph_moe2(p, 0, lds))
    PH(10, ph_prep1(p, 1))
    PH(11, ph_inproj(p, 1, lds))
    PH(12, ph_attn_ssd1(p, 1, lds))
    PH(13, ph_ssd2(p, 1))
    PH(14, ph_ssd3_prepout(p, 1, lds))
    PH(15, ph_outproj(p, 1, lds))
    PH(16, ph_prep2<false>(p, 1, lds))
    PH(17, ph_moe1(p, 1, lds))
    PH(18, ph_moe2(p, 1, lds))
    PH(19, ph_final(p))
#undef PH
}

extern "C" void kernel_launch(void* const* d_in, const int* in_sizes, int n_in, void* d_out, int out_size, void* d_ws, size_t ws_size, hipStream_t stream) {
    static int grid = 0;
    if (grid == 0) {
        if (n_in != 25 || ws_size < WS_END) { fprintf(stderr, "kernel_launch: unexpected n_in %d or ws_size %zu < %zu\n", n_in, ws_size, (size_t)WS_END); grid = -1; return; }
        int dev = 0, cus = 0, per_cu = 0;
        hipGetDevice(&dev);
        hipDeviceGetAttribute(&cus, hipDeviceAttributeMultiprocessorCount, dev);
        hipFuncSetAttribute((const void*)fwd, hipFuncAttributeMaxDynamicSharedMemorySize, LDS_BYTES);
        hipOccupancyMaxActiveBlocksPerMultiprocessor(&per_cu, (const void*)fwd, NTHR, LDS_BYTES);
        if (per_cu < 1) per_cu = 1;
        if (per_cu > 1) per_cu = 1;
        grid = cus * per_cu;
        fprintf(stderr, "kernel_launch: grid %d (%d per CU), ws need %zu have %zu\n", grid, per_cu, (size_t)WS_END, ws_size);
    }
    if (grid < 0) return;
    Params p{};
    for (int i = 0; i < 25; ++i) p.in[i] = (const float*)d_in[i];
    p.out = (float*)d_out; p.ws = (unsigned char*)d_ws;
    (void)hipMemsetAsync((unsigned char*)d_ws + WS_CTL, 0, XCD_BAR_WORDS * 4, stream);
#if N_LAUNCH_MODE == 0
    for (int ph = 0; ph < N_PHASES; ++ph) {
        p.ph_lo = ph; p.ph_hi = ph + 1;
        hipLaunchKernelGGL(fwd, dim3(grid), dim3(NTHR), LDS_BYTES, stream, p);
    }
#else
    p.ph_lo = 0; p.ph_hi = N_PHASES;
    void* args[] = {&p};
    hipError_t e = hipLaunchCooperativeKernel((const void*)fwd, dim3(grid), dim3(NTHR), args, LDS_BYTES, stream);
    if (e != hipSuccess) fprintf(stderr, "cooperative launch failed: %s (grid %d)\n", hipGetErrorString(e), grid);
#endif
}
```

```cpp
#include <hip/hip_runtime.h>
#include <hip/hip_cooperative_groups.h>
#include <cstdio>
#include <cstdint>
#include <cstddef>
namespace cg = cooperative_groups;

typedef unsigned short bf16_t;
typedef short bf16x8 __attribute__((ext_vector_type(8)));
typedef float f32x4 __attribute__((ext_vector_type(4)));
typedef unsigned u32x4 __attribute__((ext_vector_type(4)));
typedef int i32x8 __attribute__((ext_vector_type(8)));
typedef int i32x4 __attribute__((ext_vector_type(4)));

#ifndef N_LAUNCH_MODE
#define N_LAUNCH_MODE 1
#endif

constexpr int D = 1024, NBATCH = 8, S = 4096, CTX = 256;
constexpr int NL = NBATCH * S, NC = NBATCH * CTX, NT = NL + NC;
constexpr int NIN = 2176, NINV = 2064;
constexpr int NP = 2048;
constexpr int OQ = 0, OKK = 512, OV = 640, OZ = 768, OXBC = 1280, ODT = 2048;
constexpr int NE = 32;
constexpr int ACT_ROWS = NT * 4 + NE * 256;
constexpr float EPS = 1e-6f;
constexpr int NTHR = 512, NWAVE = 8;
constexpr int LDS_BYTES = 152 * 1024;

constexpr size_t al256(size_t x) { return (x + 65536 + 255) & ~(size_t)255; }
constexpr size_t WS_CTL   = 0;
constexpr size_t WS_CNT   = 65536;
constexpr size_t WS_ROPE  = WS_CNT + 4096;
constexpr size_t WS_C9    = WS_ROPE + 8192;
constexpr size_t WS_WRT   = WS_C9 + 4096;
constexpr size_t WS_MOD   = WS_WRT + (size_t)2 * 2 * 32 * 1024 * 2;
constexpr size_t WS_WIN   = al256(WS_MOD + (size_t)2 * 9 * 6144 * 4);
constexpr size_t WS_WOUT  = al256(WS_WIN + (size_t)2 * NIN * 1024 * 2);
constexpr size_t WS_WGU   = al256(WS_WOUT + (size_t)2 * 1024 * 1024 * 2);
constexpr size_t WS_WDN   = al256(WS_WGU + (size_t)64 * 2048 * 1024);
constexpr size_t WS_H     = al256(WS_WDN + (size_t)64 * 1024 * 1024);
constexpr size_t WS_P     = al256(WS_H + (size_t)NT * 1024 * 2);
constexpr size_t WS_DT    = al256(WS_P + (size_t)NT * NP * 4);
constexpr int NBLK = 34, NITEM = NBATCH * NBLK * 2;
constexpr int TPB = CTX + S;
constexpr size_t DT_STRIDE = (size_t)NT * 16 * 4 + 65536;
constexpr size_t WS_QB    = al256(WS_DT + 2 * DT_STRIDE);
constexpr size_t WS_KB    = al256(WS_QB + (size_t)NT * 512 * 2);
constexpr size_t WS_VT    = al256(WS_KB + (size_t)NT * 128 * 2);
constexpr size_t WS_UXT   = al256(WS_VT + (size_t)NBATCH * 2 * 64 * TPB * 2);
constexpr size_t WS_UBN   = al256(WS_UXT + (size_t)NITEM * 256 * 128 * 2);
constexpr size_t WS_UCN   = al256(WS_UBN + (size_t)NITEM * 128 * 64 * 2);
constexpr size_t WS_ST    = al256(WS_UCN + (size_t)NITEM * 128 * 64 * 2);
constexpr size_t WS_DEC   = al256(WS_ST + (size_t)128 * NBLK * 4096 * 4);
constexpr size_t DEC_STRIDE = (size_t)128 * NBLK * 4 + 65536;
constexpr size_t WS_HS    = al256(WS_DEC + 2 * DEC_STRIDE);
constexpr size_t WS_ATT   = al256(WS_HS + (size_t)128 * NBLK * 4096 * 2);
constexpr size_t WS_MIX   = al256(WS_ATT + (size_t)NT * 512 * 4);
constexpr size_t WS_XW    = al256(WS_MIX + (size_t)NT * 1024 * 2);
constexpr size_t WS_LIST  = al256(WS_XW + (size_t)NT * 1024 * 4);
constexpr size_t LIST_STRIDE = (size_t)NE * NT * 4 + 65536;
constexpr size_t WS_ROUTE = al256(WS_LIST + 2 * LIST_STRIDE);
constexpr size_t RG_STRIDE = (size_t)NT * 4 * 4 + 65536;
constexpr size_t WS_GATE  = al256(WS_ROUTE + 2 * RG_STRIDE);
constexpr size_t WS_ACT   = al256(WS_GATE + 2 * RG_STRIDE);
constexpr size_t WS_Y     = al256(WS_ACT + (size_t)ACT_ROWS * 1024);
constexpr size_t WS_END   = al256(WS_Y + (size_t)ACT_ROWS * 1024 * 2);

struct Params {
    const float* in[25];
    float* out;
    unsigned char* ws;
    int ph_lo, ph_hi;
};
enum { I_X = 0, I_C, I_CTX, I_CCTX, I_WADA, I_BADA, I_NMIX, I_NFFN, I_WIN, I_CONVW, I_CONVB, I_DTB, I_ALOG, I_DSKIP, I_SSMNW, I_SINK,
       I_ATTNW, I_WOUT, I_WR, I_BR, I_WGU, I_BGU, I_WDN, I_BDN, I_FNW };

typedef __bf16 hwbf16x2 __attribute__((ext_vector_type(2)));
typedef float hwf32x2 __attribute__((ext_vector_type(2)));
__device__ __forceinline__ unsigned pack2bf(float lo, float hi) { const hwf32x2 v = {lo, hi}; return __builtin_bit_cast(unsigned, __builtin_convertvector(v, hwbf16x2)); }
__device__ __forceinline__ unsigned short f2bf(float f) { return (unsigned short)(pack2bf(f, f) & 0xffffu); }
__device__ __forceinline__ float bf2f(unsigned short h) { return __uint_as_float((unsigned)h << 16); }
__device__ __forceinline__ f32x4 quad_transpose(const f32x4 x, int t) {
    const bool odd = (t & 1) != 0, hi = (t & 2) != 0;
    float p[4], b[4], q[4];
#pragma unroll
    for (int j = 0; j < 4; ++j) p[j] = __int_as_float(__builtin_amdgcn_mov_dpp(__float_as_int(x[j]), 0xB1, 0xF, 0xF, true));
    b[0] = odd ? p[1] : x[0]; b[1] = odd ? x[1] : p[0]; b[2] = odd ? p[3] : x[2]; b[3] = odd ? x[3] : p[2];
#pragma unroll
    for (int j = 0; j < 4; ++j) q[j] = __int_as_float(__builtin_amdgcn_mov_dpp(__float_as_int(b[j]), 0x4E, 0xF, 0xF, true));
    f32x4 y;
    y[0] = hi ? q[2] : b[0]; y[1] = hi ? q[3] : b[1]; y[2] = hi ? b[2] : q[0]; y[3] = hi ? b[3] : q[1];
    return y;
}
__device__ __forceinline__ bf16x8 pack8bf(float a0, float a1, float a2, float a3, float a4, float a5, float a6, float a7) {
    const u32x4 w = {pack2bf(a0, a1), pack2bf(a2, a3), pack2bf(a4, a5), pack2bf(a6, a7)};
    return __builtin_bit_cast(bf16x8, w);
}
__device__ __forceinline__ unsigned pack4fp8(float a, float b, float c, float d) {
    unsigned w = 0u;
    w = __builtin_amdgcn_cvt_pk_fp8_f32(a, b, w, false);
    w = __builtin_amdgcn_cvt_pk_fp8_f32(c, d, w, true);
    return w;
}
constexpr float F8_WSCALE = 64.f, F8_ASCALE = 4.f, F8_OSCALE = 1.f / (64.f * 4.f), F8_YSCALE = 16.f;
__device__ __forceinline__ void st_wt(float* q, float v) { __hip_atomic_store(q, v, __ATOMIC_RELAXED, __HIP_MEMORY_SCOPE_AGENT); }
__device__ __forceinline__ void st_wt(int* q, int v) { __hip_atomic_store(q, v, __ATOMIC_RELAXED, __HIP_MEMORY_SCOPE_AGENT); }
__device__ __forceinline__ float silu_f(float x) { return x / (1.f + __expf(-x)); }
__device__ __forceinline__ float wave_sum(float v) {
#pragma unroll
    for (int o = 32; o >= 1; o >>= 1) v += __shfl_xor(v, o);
    return v;
}
__device__ __forceinline__ int mod_row(int row) { return row < NL ? (row >> 12) : 8; }

#define LAS __attribute__((address_space(3)))
namespace g8 {
constexpr int BM = 256, BK = 64, HALF = 128, HTB = HALF * BK * 2, KB = 1024 * 2  ;
__device__ __forceinline__ int lds_byte(int r, int c) { const int st = (r >> 4) * 2 + (c >> 5), rr = r & 15, cc = c & 31, ob = rr * 64 + cc * 2; return st * 1024 + (ob ^ (((ob >> 9) & 1) << 5)); }
__device__ __forceinline__ void stage_rc(int b, int& R, int& C) { const int st = b / 1024, sb = b % 1024, swz = sb ^ (((sb >> 9) & 1) << 5); R = (st >> 1) * 16 + swz / 64; C = (st & 1) * 32 + (swz % 64) / 2; }

struct Unit {
    const char* a0;
    const char* b0;
    int r0, c0;
    int e, m0, cm1;
};

__device__ __forceinline__ int perm32(int rho) { const int n = rho >> 4, i = rho & 15; return 8 * (i >> 2) + 4 * n + (i & 3); }
constexpr int GTAB_OFF = 8 * HTB;
constexpr int BTAB_OFF = GTAB_OFF + 1024;
constexpr int MTAB_OFF = BTAB_OFF + 3072;
template <bool GATHER, bool PERM, class Sched, class Epi>
__device__ __forceinline__ void gemm_phase(LAS unsigned char* lds, const Sched& S, const Epi& E) {
    const int tid = threadIdx.x, wid = __builtin_amdgcn_readfirstlane(tid >> 6), lane = tid & 63, wr = wid >> 2, wc = wid & 3, fr = lane & 15, fq = lane >> 4;
    constexpr int nt = 1024 / BK;
    int Rr[2], Cc[2];
    unsigned voffB[2], vA[2][2];
#pragma unroll
    for (int i = 0; i < 2; ++i) { stage_rc(tid * 16 + i * 8192, Rr[i], Cc[i]); const int Rb = PERM ? ((Rr[i] & ~31) + perm32(Rr[i] & 31)) : Rr[i]; voffB[i] = (unsigned)(Rb * 1024 + Cc[i]) * 2u; }
    constexpr size_t kstep = (size_t)BK * 2;
    const unsigned ldsw = (unsigned)wid * 1024u;
    const int aoff = lds_byte(wr * 64 + fr, fq * 8), boff = lds_byte(wc * 32 + fr, fq * 8);
#define G8_SA(b, h) (((b) * 2 + (h)) * HTB)
#define G8_SB(b, h) ((4 + (b) * 2 + (h)) * HTB)
#define G8_STAGE(bufoff, gbase, voff) do { _Pragma("unroll") for (int _i = 0; _i < 2; ++_i) \
        __builtin_amdgcn_global_load_lds((const unsigned*)((const char*)(gbase) + (voff)[_i]), (LAS unsigned*)(lds + (bufoff) + ldsw + _i * 8192), 16, 0, 0); } while (0)
#define G8_LDA(dst, b, h) do { _Pragma("unroll") for (int m = 0; m < 4; ++m) _Pragma("unroll") for (int k = 0; k < 2; ++k) dst[m][k] = *(const LAS bf16x8*)(lds + G8_SA(b, h) + aoff + m * 2048 + k * 1024); } while (0)
#define G8_LDB(dst, b, h) do { _Pragma("unroll") for (int n = 0; n < 2; ++n) _Pragma("unroll") for (int k = 0; k < 2; ++k) dst[n][k] = *(const LAS bf16x8*)(lds + G8_SB(b, h) + boff + n * 2048 + k * 1024); } while (0)
#define G8_MMA(ai, bj, At, Bt) do { __builtin_amdgcn_s_setprio(1); _Pragma("unroll") for (int m = 0; m < 4; ++m) _Pragma("unroll") for (int n = 0; n < 2; ++n) _Pragma("unroll") for (int k = 0; k < 2; ++k) \
        acc[ai][bj][m][n] = __builtin_amdgcn_mfma_f32_16x16x32_bf16(Bt[n][k], At[m][k], acc[ai][bj][m][n], 0, 0, 0); __builtin_amdgcn_s_setprio(0); } while (0)
#define G8_WAIT_V(n) asm volatile("s_waitcnt vmcnt(" #n ")" ::: "memory")
#define G8_WAIT_L(n) asm volatile("s_waitcnt lgkmcnt(" #n ")" ::: "memory")
#define G8_BAR __builtin_amdgcn_s_barrier()
#define G8_SCHED __builtin_amdgcn_sched_barrier(0)
    Unit cur, nxt; int ui = 0;
    if (!S.next(0, cur)) return;
#pragma unroll
    for (int h = 0; h < 2; ++h)
#pragma unroll
        for (int i = 0; i < 2; ++i) vA[h][i] = GATHER ? S.aoff(cur, h, Rr[i], Cc[i]) : (unsigned)(Rr[i] * 1024 + Cc[i]) * 2u;
    f32x4 acc[2][2][4][2];
#pragma unroll
    for (int a = 0; a < 2; ++a)
#pragma unroll
        for (int b = 0; b < 2; ++b)
#pragma unroll
            for (int m = 0; m < 4; ++m)
#pragma unroll
                for (int n = 0; n < 2; ++n) acc[a][b][m][n] = (f32x4){0.f, 0.f, 0.f, 0.f};
    bf16x8 At[4][2], B0[2][2], B1[2][2];
    G8_STAGE(G8_SB(0, 0), cur.b0, voffB); G8_STAGE(G8_SA(0, 0), cur.a0, vA[0]); G8_STAGE(G8_SB(0, 1), (cur.b0 + Sched::B1OFF), voffB); G8_STAGE(G8_SA(0, 1), (cur.a0 + Sched::A1OFF), vA[1]);
    if (wr == 1) G8_BAR;
    G8_WAIT_V(4); G8_BAR;
    G8_STAGE(G8_SB(1, 0), cur.b0 + kstep, voffB); G8_STAGE(G8_SA(1, 0), cur.a0 + kstep, vA[0]); G8_STAGE(G8_SB(1, 1), (cur.b0 + Sched::B1OFF) + kstep, voffB);
    G8_WAIT_V(6); G8_BAR;
    for (;;) {
        const bool has_next = S.next(ui + 1, nxt);
        if (!has_next) nxt = cur;
        if (GATHER && has_next)
            __builtin_amdgcn_global_load_lds((const unsigned*)(S.list_ptr(nxt) + (wid & 3) * 64 + lane), (LAS unsigned*)(lds + GTAB_OFF + (wid & 3) * 256), 4, 0, 0);
#pragma unroll 1
        for (int t = 0; t < nt; t += 2) {
            const bool last = (t == nt - 2);
            const char* a1h1 = (cur.a0 + Sched::A1OFF) + (size_t)(t + 1) * kstep;
            const char* a2h0 = last ? nxt.a0 : cur.a0 + (size_t)(t + 2) * kstep; const char* a2h1 = last ? (nxt.a0 + Sched::A1OFF) : (cur.a0 + Sched::A1OFF) + (size_t)(t + 2) * kstep;
            const char* b2h0 = last ? nxt.b0 : cur.b0 + (size_t)(t + 2) * kstep; const char* b2h1 = last ? (nxt.b0 + Sched::B1OFF) : (cur.b0 + Sched::B1OFF) + (size_t)(t + 2) * kstep;
            G8_LDB(B0, 0, 0); G8_SCHED; G8_LDA(At, 0, 0); G8_STAGE(G8_SA(1, 1), a1h1, vA[1]);
            if (GATHER && last && has_next) {
                const int lim = nxt.cm1 - nxt.m0;
#pragma unroll
                for (int h = 0; h < 2; ++h)
#pragma unroll
                    for (int i = 0; i < 2; ++i) { int ix = h * 128 + Rr[i]; ix = ix > lim ? lim : ix;
                        vA[h][i] = (unsigned)(*(const LAS int*)(lds + GTAB_OFF + ix * 4)) * (unsigned)KB + (unsigned)Cc[i] * 2u; }
            }
            G8_WAIT_L(8); G8_BAR; G8_WAIT_L(0); G8_MMA(0, 0, At, B0); G8_BAR; G8_SCHED;
            G8_LDB(B1, 0, 1); G8_STAGE(G8_SB(0, 0), b2h0, voffB);
            G8_BAR; G8_WAIT_L(0); G8_MMA(0, 1, At, B1); G8_BAR;
            G8_LDA(At, 0, 1); G8_STAGE(G8_SA(0, 0), a2h0, vA[0]);
            G8_BAR; G8_WAIT_L(0); G8_MMA(1, 0, At, B0); G8_BAR; G8_SCHED;
            G8_STAGE(G8_SB(0, 1), b2h1, voffB);
            G8_WAIT_V(6); G8_BAR; G8_MMA(1, 1, At, B1); G8_BAR;
            G8_LDB(B0, 1, 0); G8_SCHED; G8_LDA(At, 1, 0); G8_STAGE(G8_SA(0, 1), a2h1, vA[1]);
            G8_WAIT_L(8); G8_BAR; G8_WAIT_L(0); G8_MMA(0, 0, At, B0); G8_BAR; G8_SCHED;
            G8_LDB(B1, 1, 1); G8_STAGE(G8_SB(1, 0), b2h0 + kstep, voffB);
            G8_BAR; G8_WAIT_L(0); G8_MMA(0, 1, At, B1); G8_BAR;
            G8_LDA(At, 1, 1); G8_STAGE(G8_SA(1, 0), a2h0 + kstep, vA[0]);
            G8_BAR; G8_WAIT_L(0); G8_MMA(1, 0, At, B0); G8_BAR; G8_SCHED;
            G8_STAGE(G8_SB(1, 1), b2h1 + kstep, voffB);
            G8_WAIT_V(6); G8_BAR; G8_MMA(1, 1, At, B1); G8_BAR;
        }
        E(acc, cur, wr, wc, fr, fq);
        if (!has_next) break;
#pragma unroll
        for (int a = 0; a < 2; ++a)
#pragma unroll
            for (int b = 0; b < 2; ++b)
#pragma unroll
                for (int m = 0; m < 4; ++m)
#pragma unroll
                    for (int n = 0; n < 2; ++n) acc[a][b][m][n] = (f32x4){0.f, 0.f, 0.f, 0.f};
        cur = nxt; ++ui;
    }
    G8_WAIT_V(0);
    if (wr == 0) G8_BAR;
    G8_BAR;
#undef G8_SA
#undef G8_SB
#undef G8_STAGE
#undef G8_LDA
#undef G8_LDB
#undef G8_MMA
#undef G8_WAIT_V
#undef G8_WAIT_L
#undef G8_BAR
#undef G8_SCHED
}

template <bool GATHER, bool PERM, class Sched, class Epi>
__device__ __forceinline__ void gemm_phase_f8(LAS unsigned char* lds, const Sched& S, const Epi& E) {
    const int tid = threadIdx.x, wid = __builtin_amdgcn_readfirstlane(tid >> 6), lane = tid & 63, wr = wid >> 2, wc = wid & 3, fr = lane & 15, fq = lane >> 4;
    constexpr int nt = 8, ROWB = 1024;
    int Rr[2], Cc[2];
    unsigned voffB[2], vA[2][2];
#pragma unroll
    for (int i = 0; i < 2; ++i) { stage_rc(tid * 16 + i * 8192, Rr[i], Cc[i]); const int Rb = PERM ? ((Rr[i] & ~31) + perm32(Rr[i] & 31)) : Rr[i]; voffB[i] = (unsigned)(Rb * ROWB + Cc[i] * 2); }
    constexpr size_t kstep = (size_t)BK * 2;
    const unsigned ldsw = (unsigned)wid * 1024u;
    const int aoff = lds_byte(wr * 64 + fr, fq * 16), boff = lds_byte(wc * 32 + fr, fq * 16);
#define G8_SA(b, h) (((b) * 2 + (h)) * HTB)
#define G8_SB(b, h) ((4 + (b) * 2 + (h)) * HTB)
#define G8_STAGE(bufoff, gbase, voff) do { _Pragma("unroll") for (int _i = 0; _i < 2; ++_i) \
        __builtin_amdgcn_global_load_lds((const unsigned*)((const char*)(gbase) + (voff)[_i]), (LAS unsigned*)(lds + (bufoff) + ldsw + _i * 8192), 16, 0, 0); } while (0)
#define G8_LDA(dst, b, h) do { _Pragma("unroll") for (int m = 0; m < 4; ++m) { const u32x4 _lo = *(const LAS u32x4*)(lds + G8_SA(b, h) + aoff + m * 2048), _hi = *(const LAS u32x4*)(lds + G8_SA(b, h) + aoff + m * 2048 + 16); \
        dst[m] = __builtin_shufflevector(__builtin_bit_cast(i32x4, _lo), __builtin_bit_cast(i32x4, _hi), 0, 1, 2, 3, 4, 5, 6, 7); } } while (0)
#define G8_LDB(dst, b, h) do { _Pragma("unroll") for (int n = 0; n < 2; ++n) { const u32x4 _lo = *(const LAS u32x4*)(lds + G8_SB(b, h) + boff + n * 2048), _hi = *(const LAS u32x4*)(lds + G8_SB(b, h) + boff + n * 2048 + 16); \
        dst[n] = __builtin_shufflevector(__builtin_bit_cast(i32x4, _lo), __builtin_bit_cast(i32x4, _hi), 0, 1, 2, 3, 4, 5, 6, 7); } } while (0)
#define G8_MMA(ai, bj, At, Bt) do { __builtin_amdgcn_s_setprio(1); _Pragma("unroll") for (int m = 0; m < 4; ++m) _Pragma("unroll") for (int n = 0; n < 2; ++n) \
        asm volatile("v_mfma_scale_f32_16x16x128_f8f6f4 %0, %1, %2, %0, %3, %3 op_sel_hi:[0,0,0]" : "+v"(acc[ai][bj][m][n]) : "v"(Bt[n]), "v"(At[m]), "v"(scl)); __builtin_amdgcn_s_setprio(0); } while (0)
#define G8_WAIT_V(n) asm volatile("s_waitcnt vmcnt(" #n ")" ::: "memory")
#define G8_WAIT_L(n) asm volatile("s_waitcnt lgkmcnt(" #n ")" ::: "memory")
#define G8_BAR __builtin_amdgcn_s_barrier()
#define G8_SCHED __builtin_amdgcn_sched_barrier(0)
    Unit cur, nxt; int ui = 0;
    if (!S.next(0, cur)) return;
#pragma unroll
    for (int h = 0; h < 2; ++h)
#pragma unroll
        for (int i = 0; i < 2; ++i) vA[h][i] = GATHER ? S.aoff(cur, h, Rr[i], Cc[i]) : (unsigned)(Rr[i] * ROWB + Cc[i] * 2);
    f32x4 acc[2][2][4][2];
#pragma unroll
    for (int a = 0; a < 2; ++a)
#pragma unroll
        for (int b = 0; b < 2; ++b)
#pragma unroll
            for (int m = 0; m < 4; ++m)
#pragma unroll
                for (int n = 0; n < 2; ++n) acc[a][b][m][n] = (f32x4){0.f, 0.f, 0.f, 0.f};
    i32x8 At[4], B0[2], B1[2];
    const int scl = 0x7F7F7F7F;
#define G8_BIAS_DMA(unit, par) __builtin_amdgcn_global_load_lds((const unsigned*)(E.bias_ptr(unit, wid & 3) + lane), (LAS unsigned*)(lds + BTAB_OFF + (par) * 1024 + (wid & 3) * 256), 4, 0, 0)
    G8_BIAS_DMA(cur, 0);
    G8_STAGE(G8_SB(0, 0), cur.b0, voffB); G8_STAGE(G8_SA(0, 0), cur.a0, vA[0]); G8_STAGE(G8_SB(0, 1), (cur.b0 + Sched::B1OFF), voffB); G8_STAGE(G8_SA(0, 1), (cur.a0 + Sched::A1OFF), vA[1]);
    if (wr == 1) G8_BAR;
    G8_WAIT_V(4); G8_BAR;
    G8_STAGE(G8_SB(1, 0), cur.b0 + kstep, voffB); G8_STAGE(G8_SA(1, 0), cur.a0 + kstep, vA[0]); G8_STAGE(G8_SB(1, 1), (cur.b0 + Sched::B1OFF) + kstep, voffB);
    G8_WAIT_V(6); G8_BAR;
    for (;;) {
        const bool has_next = S.next(ui + 1, nxt);
        if (!has_next) nxt = cur;
            if (has_next) G8_BIAS_DMA(nxt, (ui + 1) % 3);
        if (GATHER && has_next)
            __builtin_amdgcn_global_load_lds((const unsigned*)(S.list_ptr(nxt) + (wid & 3) * 64 + lane), (LAS unsigned*)(lds + GTAB_OFF + (wid & 3) * 256), 4, 0, 0);
#pragma unroll 1
        for (int t = 0; t < nt; t += 2) {
            const bool last = (t == nt - 2);
            const char* a1h1 = (cur.a0 + Sched::A1OFF) + (size_t)(t + 1) * kstep;
            const char* a2h0 = last ? nxt.a0 : cur.a0 + (size_t)(t + 2) * kstep; const char* a2h1 = last ? (nxt.a0 + Sched::A1OFF) : (cur.a0 + Sched::A1OFF) + (size_t)(t + 2) * kstep;
            const char* b2h0 = last ? nxt.b0 : cur.b0 + (size_t)(t + 2) * kstep; const char* b2h1 = last ? (nxt.b0 + Sched::B1OFF) : (cur.b0 + Sched::B1OFF) + (size_t)(t + 2) * kstep;
            G8_LDB(B0, 0, 0); G8_SCHED; G8_LDA(At, 0, 0); G8_STAGE(G8_SA(1, 1), a1h1, vA[1]);
            if (GATHER && last && has_next) {
                const int lim = nxt.cm1 - nxt.m0;
#pragma unroll
                for (int h = 0; h < 2; ++h)
#pragma unroll
                    for (int i = 0; i < 2; ++i) { int ix = h * 128 + Rr[i]; ix = ix > lim ? lim : ix;
                        vA[h][i] = (unsigned)(*(const LAS int*)(lds + GTAB_OFF + ix * 4)) * (unsigned)ROWB + (unsigned)Cc[i] * 2u; }
            }
            G8_WAIT_L(8); G8_BAR; G8_WAIT_L(0); G8_MMA(0, 0, At, B0); G8_BAR; G8_SCHED;
            G8_LDB(B1, 0, 1); G8_STAGE(G8_SB(0, 0), b2h0, voffB);
            G8_BAR; G8_WAIT_L(0); G8_MMA(0, 1, At, B1); G8_BAR;
            G8_LDA(At, 0, 1); G8_STAGE(G8_SA(0, 0), a2h0, vA[0]);
            G8_BAR; G8_WAIT_L(0); G8_MMA(1, 0, At, B0); G8_BAR; G8_SCHED;
            G8_STAGE(G8_SB(0, 1), b2h1, voffB);
            G8_WAIT_V(6); G8_BAR; G8_MMA(1, 1, At, B1); G8_BAR;
            G8_LDB(B0, 1, 0); G8_SCHED; G8_LDA(At, 1, 0); G8_STAGE(G8_SA(0, 1), a2h1, vA[1]);
            G8_WAIT_L(8); G8_BAR; G8_WAIT_L(0); G8_MMA(0, 0, At, B0); G8_BAR; G8_SCHED;
            G8_LDB(B1, 1, 1); G8_STAGE(G8_SB(1, 0), b2h0 + kstep, voffB);
            G8_BAR; G8_WAIT_L(0); G8_MMA(0, 1, At, B1); G8_BAR;
            G8_LDA(At, 1, 1); G8_STAGE(G8_SA(1, 0), a2h0 + kstep, vA[0]);
            G8_BAR; G8_WAIT_L(0); G8_MMA(1, 0, At, B0); G8_BAR; G8_SCHED;
            G8_STAGE(G8_SB(1, 1), b2h1 + kstep, voffB);
            G8_WAIT_V(6); G8_BAR; G8_MMA(1, 1, At, B1); G8_BAR;
        }
        asm volatile("s_nop 15\n\ts_nop 15" ::: "memory");
        E(acc, cur, wr, wc, fr, fq, (const LAS float*)(lds + BTAB_OFF + (ui % 3) * 1024));
        if (!has_next) break;
#pragma unroll
        for (int a = 0; a < 2; ++a)
#pragma unroll
            for (int b = 0; b < 2; ++b)
#pragma unroll
                for (int m = 0; m < 4; ++m)
#pragma unroll
                    for (int n = 0; n < 2; ++n) acc[a][b][m][n] = (f32x4){0.f, 0.f, 0.f, 0.f};
        cur = nxt; ++ui;
    }
    G8_WAIT_V(0);
    if (wr == 0) G8_BAR;
    G8_BAR;
#undef G8_BIAS_DMA
#undef G8_SA
#undef G8_SB
#undef G8_STAGE
#undef G8_LDA
#undef G8_LDB
#undef G8_MMA
#undef G8_WAIT_V
#undef G8_WAIT_L
#undef G8_BAR
#undef G8_SCHED
}

struct DenseOrder {
    static constexpr size_t A1OFF = (size_t)128 * KB, B1OFF = (size_t)128 * KB;
    const char* A; const char* B; int nM, nN, nwg, G, c;
    __device__ __forceinline__ void init(const void* A_, const void* B_, int M, int N) { A = (const char*)A_; B = (const char*)B_; nM = M / 256; nN = N / 256; nwg = nM * nN; G = gridDim.x; c = blockIdx.x; }
    __device__ __forceinline__ bool next(int i, Unit& u) const {
        const int L = i * G + c; if (L >= nwg) return false;
        int wgid = L; { const int q = nwg / 8, r = nwg % 8, xcd = wgid % 8, off = wgid / 8; wgid = (xcd < r ? xcd * (q + 1) : r * (q + 1) + (xcd - r) * q) + off; }
        const int nig = 8 * nN, gid = wgid / nig, fm = gid * 8, gsz = (nM - fm) < 8 ? (nM - fm) : 8;
        const int pm = fm + ((wgid % nig) % gsz), pn = (wgid % nig) / gsz;
        u.a0 = A + (size_t)pm * 256 * KB; u.b0 = B + (size_t)pn * 256 * KB;
        u.r0 = pm * 256; u.c0 = pn * 256; u.e = 0; u.m0 = 0; u.cm1 = 0; return true;
    }
    __device__ __forceinline__ unsigned aoff(const Unit&, int, int, int) const { return 0u; }
    __device__ __forceinline__ const int* list_ptr(const Unit&) const { return nullptr; }
};
template <bool GATE_UP, int ROWB>
struct MoeOrder {
    const int* cnt; const int* list; const char* A; const char* W; int G, c; const LAS int* tab;
    static constexpr int NTN = GATE_UP ? 8 : 4;
    __device__ __forceinline__ void prepare(LAS int* t) {
        tab = t;
        if (threadIdx.x < 33) { int acc = 0; for (int e = 0; e < (int)threadIdx.x; ++e) acc += (cnt[e] + 255) >> 8; t[threadIdx.x] = acc; }
        else if (threadIdx.x >= 64 && threadIdx.x < 96) t[40 + threadIdx.x - 64] = cnt[threadIdx.x - 64];
        __syncthreads();
    }
    static constexpr size_t A1OFF = GATE_UP ? 0 : (size_t)128 * ROWB, B1OFF = GATE_UP ? (size_t)1024 * ROWB : (size_t)128 * ROWB;
    __device__ __forceinline__ const int* list_ptr(const Unit& u) const { return list + (size_t)u.e * NT + u.m0; }
    __device__ __forceinline__ bool next(int i, Unit& u) const {
        int tile, nt;
        if (G == 256) {
            const int x = c & 7, w = c >> 3;
            if (GATE_UP) { nt = (x & 1) * 4 + (w & 3); tile = i * 32 + (x >> 1) * 8 + (w >> 2); }
            else         { nt = w & 3;                 tile = i * 64 + x * 8 + (w >> 2); }
        } else { const int L = i * G + c; tile = L / NTN; nt = L % NTN; }
        const int ln = (int)(threadIdx.x & 31);
        const int ts = tab[ln], te = tab[ln + 1], cn = tab[40 + ln];
        const unsigned long long hit = __ballot(tile >= ts && tile < te);
        if (hit == 0ull) return false;
        const int fe = __builtin_amdgcn_readfirstlane(__builtin_ctzll(hit) & 31);
        const int fst = __builtin_amdgcn_readlane(ts, fe), fc = __builtin_amdgcn_readlane(cn, fe);
        const int fmt = tile - fst, fbase = fst * 256;
        u.e = fe; u.m0 = fmt * 256; u.cm1 = fc - 1; u.r0 = fbase + fmt * 256;
        if (GATE_UP) {
            u.a0 = A;
            u.b0 = W + ((size_t)fe * 2048 + (size_t)nt * 128) * ROWB; u.c0 = nt * 128;
        } else {
            u.a0 = A + (size_t)u.r0 * ROWB;
            u.b0 = W + ((size_t)fe * 1024 + (size_t)nt * 256) * ROWB; u.c0 = nt * 256;
        }
        return true;
    }
    __device__ __forceinline__ unsigned aoff(const Unit& u, int h, int R, int C) const {
        int i = u.m0 + h * 128 + R; i = i > u.cm1 ? u.cm1 : i;
        return (unsigned)list[(size_t)u.e * NT + i] * (unsigned)ROWB + (unsigned)C * 2u;
    }
};

struct EpiInproj {
    bf16_t* P; bf16_t* QB; bf16_t* KB; bf16_t* VT; const float* RC; const float* RS;
    __device__ __forceinline__ void operator()(const f32x4 (&acc)[2][2][4][2], const Unit& u, int wr, int wc, int fr, int fq) const {
        const int pn = u.c0 >> 8;
        if (pn >= 3) {
#pragma unroll
            for (int ai = 0; ai < 2; ++ai)
#pragma unroll
                for (int mp = 0; mp < 2; ++mp) {
                    bf16_t* rowp = P + (size_t)(u.r0 + ai * 128 + wr * 64 + (mp * 2 + (fq & 1)) * 16 + fr) * NP + u.c0 + wc * 32 + 4 * (fq & 2);
#pragma unroll
                    for (int bj = 0; bj < 2; ++bj)
#pragma unroll
                        for (int n = 0; n < 2; ++n) {
                            const f32x4 va = acc[ai][bj][mp * 2][n], vb = acc[ai][bj][mp * 2 + 1][n];
                            const auto r0 = __builtin_amdgcn_permlane16_swap(pack2bf(va[0], va[1]), pack2bf(vb[0], vb[1]), false, false);
                            const auto r1 = __builtin_amdgcn_permlane16_swap(pack2bf(va[2], va[3]), pack2bf(vb[2], vb[3]), false, false);
                            const u32x4 o = {r0[0], r1[0], r0[1], r1[1]};
                            *(u32x4*)(rowp + bj * 128 + n * 16) = o;
                        }
                }
            return;
        }
        const bool latent = u.r0 < NL;
#pragma unroll
        for (int ai = 0; ai < 2; ++ai)
#pragma unroll
            for (int m = 0; m < 4; ++m) {
                const int row = u.r0 + ai * 128 + wr * 64 + m * 16 + fr;
                const int tok = row & (S - 1);
                const int pos = (wc & 1) ? (tok & 63) : (tok >> 6);
                f32x4 cs = (f32x4){1.f, 1.f, 1.f, 1.f}, sn = (f32x4){0.f, 0.f, 0.f, 0.f};
                if (latent) { cs = *(const f32x4*)(RC + pos * 16 + 4 * fq); sn = *(const f32x4*)(RS + pos * 16 + 4 * fq); }
#pragma unroll
                for (int bj = 0; bj < 2; ++bj) {
                    const f32x4 v0 = acc[ai][bj][m][0], v1 = acc[ai][bj][m][1];
                    if (pn == 2 && bj == 1) {
                        const int bb = latent ? (row >> 12) : ((row - NL) >> 8), tp = latent ? CTX + tok : ((row - NL) & (CTX - 1));
                        const int tq4 = fr & 3;
                        bf16_t* vt = VT + ((size_t)(bb * 2 + (wc >> 1)) * 64 + (wc & 1) * 32 + 4 * fq + tq4) * TPB + (tp - tq4);
                        const f32x4 y0 = quad_transpose(v0, tq4), y1 = quad_transpose(v1, tq4);
                        uint2 w0, w1; w0.x = pack2bf(y0[0], y0[1]); w0.y = pack2bf(y0[2], y0[3]); w1.x = pack2bf(y1[0], y1[1]); w1.y = pack2bf(y1[2], y1[3]);
                        *(uint2*)vt = w0; *(uint2*)(vt + (size_t)16 * TPB) = w1;
                    } else {
                        const float sc = pn == 2 ? 1.f : 0.125f * 1.4426950408889634f;
                        const f32x4 o0 = (v0 * cs - v1 * sn) * sc, o1 = (v1 * cs + v0 * sn) * sc;
                        bf16_t* dst = pn == 2 ? KB + (size_t)row * 128 + wc * 32 + 4 * fq : QB + (size_t)row * 512 + u.c0 + bj * 128 + wc * 32 + 4 * fq;
                        uint2 w0, w1; w0.x = pack2bf(o0[0], o0[1]); w0.y = pack2bf(o0[2], o0[3]); w1.x = pack2bf(o1[0], o1[1]); w1.y = pack2bf(o1[2], o1[3]);
                        *(uint2*)dst = w0; *(uint2*)(dst + 16) = w1;
                    }
                }
            }
    }
};
struct EpiResid {
    float* X; const float* modl;
    __device__ __forceinline__ void operator()(const f32x4 (&acc)[2][2][4][2], const Unit& u, int wr, int wc, int fr, int fq) const {
        const float* g1 = modl + (size_t)mod_row(u.r0) * 6144 + u.c0 + wc * 32 + 4 * fq;
        f32x4 gv[2][2];
#pragma unroll
        for (int bj = 0; bj < 2; ++bj)
#pragma unroll
            for (int n = 0; n < 2; ++n) gv[bj][n] = *(const f32x4*)(g1 + bj * 128 + n * 16);
#pragma unroll
        for (int ai = 0; ai < 2; ++ai)
#pragma unroll
            for (int m = 0; m < 4; ++m) {
                float* rowp = X + (size_t)(u.r0 + ai * 128 + wr * 64 + m * 16 + fr) * 1024 + u.c0 + wc * 32 + 4 * fq;
#pragma unroll
                for (int bj = 0; bj < 2; ++bj)
#pragma unroll
                    for (int n = 0; n < 2; ++n) { f32x4* q = (f32x4*)(rowp + bj * 128 + n * 16); *q = *q + gv[bj][n] * acc[ai][bj][m][n]; }
                asm volatile("" ::: "memory");
            }
    }
};
struct EpiSwigluF8 {
    unsigned char* ACT; const float* bgl;
    __device__ __forceinline__ const float* bias_ptr(const Unit& u, int chunk) const { return bgl + (size_t)u.e * 2048 + u.c0 + (chunk >> 1) * 1024 + (chunk & 1) * 64; }
    __device__ __forceinline__ void operator()(const f32x4 (&acc)[2][2][4][2], const Unit& u, int wr, int wc, int fr, int fq, const LAS float* bl) const {
        asm volatile("" : "+v"(fr), "+v"(fq));
        f32x4 bgv[2], blv[2];
#pragma unroll
        for (int n = 0; n < 2; ++n) { bgv[n] = *(const LAS f32x4*)(bl + wc * 32 + 8 * fq + n * 4); blv[n] = *(const LAS f32x4*)(bl + 128 + wc * 32 + 8 * fq + n * 4); }
#pragma unroll
        for (int ai = 0; ai < 2; ++ai)
#pragma unroll
            for (int m = 0; m < 4; ++m) {
                unsigned char* rowp = ACT + (size_t)(u.r0 + ai * 128 + wr * 64 + m * 16 + fr) * 1024 + u.c0 + wc * 32 + 8 * fq;
                float a[8];
#pragma unroll
                for (int n = 0; n < 2; ++n) {
                    const f32x4 gl = acc[ai][0][m][n] * F8_OSCALE + bgv[n], li = acc[ai][1][m][n] * F8_OSCALE + blv[n];
#pragma unroll
                    for (int j = 0; j < 4; ++j) {
                        const float gq = fminf(gl[j], 7.f), lv = __builtin_amdgcn_fmed3f(li[j], -7.f, 7.f);
                        a[n * 4 + j] = (gq * __builtin_amdgcn_rcpf(1.f + __builtin_amdgcn_exp2f(gq * (-1.702f * 1.4426950408889634f)))) * (lv * F8_ASCALE + F8_ASCALE);
                    }
                }
                uint2 w; w.x = pack4fp8(a[0], a[1], a[2], a[3]); w.y = pack4fp8(a[4], a[5], a[6], a[7]);
                *(uint2*)rowp = w;
            }
    }
};
struct EpiBiasBf16 {
    unsigned char* Y; const float* bdl;
    __device__ __forceinline__ const float* bias_ptr(const Unit& u, int chunk) const { return bdl + (size_t)u.e * 1024 + u.c0 + chunk * 64; }
    __device__ __forceinline__ void operator()(const f32x4 (&acc)[2][2][4][2], const Unit& u, int wr, int wc, int fr, int fq, const LAS float* bl) const {
        f32x4 bv[2][2];
#pragma unroll
        for (int bj = 0; bj < 2; ++bj)
#pragma unroll
            for (int n = 0; n < 2; ++n) bv[bj][n] = *(const LAS f32x4*)(bl + bj * 128 + wc * 32 + 8 * fq + n * 4) * F8_YSCALE;
#pragma unroll
        for (int ai = 0; ai < 2; ++ai)
#pragma unroll
            for (int mp = 0; mp < 2; ++mp) {
                unsigned char* rowp = Y + (size_t)(u.r0 + ai * 128 + wr * 64 + (mp * 2 + (fq & 1)) * 16 + fr) * 1024 + u.c0 + wc * 32 + 8 * (fq & 2);
#pragma unroll
                for (int bj = 0; bj < 2; ++bj) {
                    uint2 w[2];
#pragma unroll
                    for (int mi = 0; mi < 2; ++mi) {
                        const f32x4 v0 = acc[ai][bj][mp * 2 + mi][0] * (F8_OSCALE * F8_YSCALE) + bv[bj][0], v1 = acc[ai][bj][mp * 2 + mi][1] * (F8_OSCALE * F8_YSCALE) + bv[bj][1];
                        w[mi].x = pack4fp8(v0[0], v0[1], v0[2], v0[3]); w[mi].y = pack4fp8(v1[0], v1[1], v1[2], v1[3]);
                    }
                    const auto r0 = __builtin_amdgcn_permlane16_swap(w[0].x, w[1].x, false, false), r1 = __builtin_amdgcn_permlane16_swap(w[0].y, w[1].y, false, false);
                    const u32x4 o = {r0[0], r1[0], r0[1], r1[1]};
                    *(u32x4*)(rowp + bj * 128) = o;
                }
            }
    }
};
}

__device__ __forceinline__ void transpose_tile(unsigned char* lds, const float* src, int ldn, int nvalid, bf16_t* dst, int k0, int n0) {
    float* T = (float*)lds;
    const int tid = threadIdx.x;
#pragma unroll
    for (int i = 0; i < 2; ++i) {
        const int r = (tid >> 4) + 32 * i, c4 = (tid & 15) * 4, n = n0 + c4;
        float4 v = make_float4(0.f, 0.f, 0.f, 0.f);
        if (n < nvalid) v = *(const float4*)(src + (size_t)(k0 + r) * ldn + n);
        T[r * 65 + c4 + 0] = v.x; T[r * 65 + c4 + 1] = v.y; T[r * 65 + c4 + 2] = v.z; T[r * 65 + c4 + 3] = v.w;
    }
    __syncthreads();
    {
        const int n = tid >> 3, kc = tid & 7;
        float v[8];
#pragma unroll
        for (int j = 0; j < 8; ++j) v[j] = T[(kc * 8 + j) * 65 + n];
        uint4 w; w.x = pack2bf(v[0], v[1]); w.y = pack2bf(v[2], v[3]); w.z = pack2bf(v[4], v[5]); w.w = pack2bf(v[6], v[7]);
        *(uint4*)(dst + (size_t)(n0 + n) * 1024 + k0 + kc * 8) = w;
    }
    __syncthreads();
}

__device__ __forceinline__ void transpose_tile_f8(unsigned char* lds, const float* src, int ldn, unsigned char* dst, int k0, int n0) {
    float* T = (float*)lds;
    const int tid = threadIdx.x;
#pragma unroll
    for (int i = 0; i < 2; ++i) {
        const int r = (tid >> 4) + 32 * i, c4 = (tid & 15) * 4;
        const float4 v = *(const float4*)(src + (size_t)(k0 + r) * ldn + n0 + c4);
        T[r * 65 + c4 + 0] = v.x; T[r * 65 + c4 + 1] = v.y; T[r * 65 + c4 + 2] = v.z; T[r * 65 + c4 + 3] = v.w;
    }
    __syncthreads();
    {
        const int n = tid >> 3, kc = tid & 7;
        float v[8];
#pragma unroll
        for (int j = 0; j < 8; ++j) v[j] = T[(kc * 8 + j) * 65 + n] * F8_WSCALE;
        uint2 w; w.x = pack4fp8(v[0], v[1], v[2], v[3]); w.y = pack4fp8(v[4], v[5], v[6], v[7]);
        *(uint2*)(dst + (size_t)(n0 + n) * 1024 + k0 + kc * 8) = w;
    }
    __syncthreads();
}

constexpr int CV_T0 = 16 * 34, CV_T1 = CV_T0 + 256, CV_T2 = CV_T1 + 32 * 512, CV_TT = CV_T2 + 32 * 256, CV_NPAIR = CV_TT / 2;
struct CvTile { const float* src; unsigned char* dst; int ldn, nv, k0, n0, kind; };
__device__ __forceinline__ CvTile cv_decode(const Params& p, int l, int it) {
    CvTile t;
    if (it < CV_T0) { const int r = it; t.k0 = (r / 34) * 64; t.n0 = (r % 34) * 64; t.src = p.in[I_WIN] + (size_t)l * 1024 * NINV; t.ldn = NINV; t.nv = NINV; t.dst = p.ws + WS_WIN + (size_t)l * NIN * 1024 * 2; t.kind = 0; }
    else if (it < CV_T1) { const int r = it - CV_T0; t.k0 = (r / 16) * 64; t.n0 = (r % 16) * 64; t.src = p.in[I_WOUT] + (size_t)l * 1024 * 1024; t.ldn = 1024; t.nv = 1024; t.dst = p.ws + WS_WOUT + (size_t)l * 1024 * 1024 * 2; t.kind = 0; }
    else if (it < CV_T2) { const int i2 = it - CV_T1, le = l * 32 + i2 / 512, r = i2 % 512; t.k0 = (r % 16) * 64; t.n0 = (r / 16) * 64; t.src = p.in[I_WGU] + (size_t)le * 1024 * 2048; t.ldn = 2048; t.nv = 2048; t.dst = p.ws + WS_WGU + (size_t)le * 2048 * 1024; t.kind = 1; }
    else { const int i2 = it - CV_T2, le = l * 32 + i2 / 256, r = i2 % 256; t.k0 = (r % 16) * 64; t.n0 = (r / 16) * 64; t.src = p.in[I_WDN] + (size_t)le * 1024 * 1024; t.ldn = 1024; t.nv = 1024; t.dst = p.ws + WS_WDN + (size_t)le * 1024 * 1024; t.kind = 1; }
    return t;
}
__device__ __forceinline__ void convert_pairs(const Params& p, unsigned char* lds, int l, int q_first, int q_stride, int q_end) {
    constexpr int D = 4;
    const int tid = threadIdx.x;
    float* T = (float*)lds;
    const int npair = (q_first < q_end) ? (q_end - q_first + q_stride - 1) / q_stride : 0, ntile = 2 * npair;
    const int lr = tid >> 4, lc4 = (tid & 15) * 4;
    float4 pv[D][2];
    __syncthreads();
#pragma unroll
    for (int d = 0; d < D; ++d) {
#pragma unroll
        for (int i = 0; i < 2; ++i) pv[d][i] = make_float4(0.f, 0.f, 0.f, 0.f);
        if (d < ntile) {
            const CvTile t = cv_decode(p, l, 2 * (q_first + (d >> 1) * q_stride) + (d & 1));
#pragma unroll
            for (int i = 0; i < 2; ++i) if (t.n0 + lc4 < t.nv) pv[d][i] = *(const float4*)(t.src + (size_t)(t.k0 + lr + 32 * i) * t.ldn + t.n0 + lc4);
        }
    }
#pragma unroll 1
    for (int s0 = 0; s0 < ntile; s0 += D) {
#pragma unroll
        for (int d = 0; d < D; ++d) {
            const int s = s0 + d;
            if (s < ntile) {
                float* Tp = T + (d & 1) * 64 * 65;
#pragma unroll
                for (int i = 0; i < 2; ++i) { float* q = Tp + (lr + 32 * i) * 65 + lc4; q[0] = pv[d][i].x; q[1] = pv[d][i].y; q[2] = pv[d][i].z; q[3] = pv[d][i].w; }
                __syncthreads();
                if (s + D < ntile) {
                    const int s2 = s + D;
                    const CvTile t = cv_decode(p, l, 2 * (q_first + (s2 >> 1) * q_stride) + (s2 & 1));
#pragma unroll
                    for (int i = 0; i < 2; ++i) { pv[d][i] = make_float4(0.f, 0.f, 0.f, 0.f); if (t.n0 + lc4 < t.nv) pv[d][i] = *(const float4*)(t.src + (size_t)(t.k0 + lr + 32 * i) * t.ldn + t.n0 + lc4); }
                }
                const CvTile c = cv_decode(p, l, 2 * (q_first + (s >> 1) * q_stride) + (s & 1));
                const int n = tid >> 3, kc = tid & 7;
                float v[8];
#pragma unroll
                for (int j = 0; j < 8; ++j) v[j] = Tp[(kc * 8 + j) * 65 + n];
                if (c.kind == 0) {
                    uint4 w; w.x = pack2bf(v[0], v[1]); w.y = pack2bf(v[2], v[3]); w.z = pack2bf(v[4], v[5]); w.w = pack2bf(v[6], v[7]);
                    *(uint4*)(c.dst + ((size_t)(c.n0 + n) * 1024 + c.k0 + kc * 8) * 2) = w;
                } else {
                    uint2 w; w.x = pack4fp8(v[0] * F8_WSCALE, v[1] * F8_WSCALE, v[2] * F8_WSCALE, v[3] * F8_WSCALE); w.y = pack4fp8(v[4] * F8_WSCALE, v[5] * F8_WSCALE, v[6] * F8_WSCALE, v[7] * F8_WSCALE);
                    *(uint2*)(c.dst + (size_t)(c.n0 + n) * 1024 + c.k0 + kc * 8) = w;
                }
            }
        }
    }
    __syncthreads();
}
constexpr int CV_Q0 = 1920, CV_Q1 = CV_Q0 + 2912, CV_Q2 = CV_Q1 + 3584;
__device__ __forceinline__ void convert_tail(const Params& p, unsigned char* lds, int slot, int nunits) {
    const int G = gridDim.x, c = blockIdx.x, first = nunits % G;
    if (c < first) return;
    const int lo = (slot == 0) ? 0 : (slot == 1) ? CV_Q0 : (slot == 2) ? CV_Q1 : CV_Q2, hi = (slot == 0) ? CV_Q0 : (slot == 1) ? CV_Q1 : (slot == 2) ? CV_Q2 : CV_NPAIR;
    convert_pairs(p, lds, 1, lo + (c - first), G - first, hi);
}


__device__ __forceinline__ void ph_setup(const Params& p, unsigned char* lds) {
    const int tid = threadIdx.x, G = gridDim.x, bid = blockIdx.x;
    if (bid == 0) {
        int* cnt = (int*)(p.ws + WS_CNT);
        if (tid < 64) cnt[tid] = 0;
        float* rc = (float*)(p.ws + WS_ROPE);
        for (int i = tid; i < 1024; i += NTHR) {
            const int pos = i >> 4, f = i & 15;
            double th = 1.0;
            for (int q = 0; q < f; ++q) th *= 0.56234132519034908;
            const double t2 = th * th;
            double c1 = 1.0, s1 = th, tc = 1.0, tsn = th;
            for (int q = 1; q <= 12; ++q) {
                tc *= -t2 / (double)((2 * q - 1) * (2 * q));
                tsn *= -t2 / (double)((2 * q) * (2 * q + 1));
                c1 += tc; s1 += tsn;
            }
            double cc = 1.0, ss = 0.0;
            for (int q = 0; q < pos; ++q) { const double nc = cc * c1 - ss * s1, ns = ss * c1 + cc * s1; cc = nc; ss = ns; }
            rc[i] = (float)cc; rc[1024 + i] = (float)ss;
        }
    }
    for (int idx = bid * NTHR + tid; idx < 2 * 32 * 1024; idx += G * NTHR) {
        const int l = idx >> 15, e = (idx >> 10) & 31, k = idx & 1023;
        const float w = p.in[I_WR][((size_t)l * 1024 + k) * 32 + e];
        const unsigned short hi = f2bf(w), lo = f2bf(w - bf2f(hi));
        bf16_t* WRT = (bf16_t*)(p.ws + WS_WRT) + (size_t)l * 2 * 32 * 1024;
        WRT[e * 1024 + k] = hi; WRT[32 * 1024 + e * 1024 + k] = lo;
    }
    {
        float* sil = (float*)lds;
        float* part = sil + 9 * 1024;
        float* MOD = (float*)(p.ws + WS_MOD);
        const int wid = tid >> 6, lane = tid & 63;
        for (int it = bid; it < 192; it += G) {
            const int l = it / 96, j0 = (it % 96) * 64;
            for (int idx = tid; idx < 9 * 1024; idx += NTHR) {
                const int r = idx >> 10, k = idx & 1023;
                const float v = r < 8 ? p.in[I_C][r * 1024 + k] : p.in[I_CCTX][k];
                sil[idx] = silu_f(v);
            }
            __syncthreads();
            float acc[9];
#pragma unroll
            for (int r = 0; r < 9; ++r) acc[r] = 0.f;
            const float* w = p.in[I_WADA] + (size_t)l * 1024 * 6144 + j0 + lane;
#pragma unroll 1
            for (int k0 = wid * 128; k0 < wid * 128 + 128; k0 += 16) {
                float wv[16];
#pragma unroll
                for (int u = 0; u < 16; ++u) wv[u] = w[(size_t)(k0 + u) * 6144];
#pragma unroll
                for (int u = 0; u < 16; ++u)
#pragma unroll
                    for (int r = 0; r < 9; ++r) acc[r] += sil[r * 1024 + k0 + u] * wv[u];
            }
#pragma unroll
            for (int r = 0; r < 9; ++r) part[(wid * 9 + r) * 64 + lane] = acc[r];
            __syncthreads();
            for (int idx = tid; idx < 9 * 64; idx += NTHR) {
                const int r = idx >> 6, c = idx & 63;
                float s = 0.f;
#pragma unroll
                for (int w8 = 0; w8 < 8; ++w8) s += part[(w8 * 9 + r) * 64 + c];
                MOD[(size_t)(l * 9 + r) * 6144 + j0 + c] = s + p.in[I_BADA][l * 6144 + j0 + c];
            }
            __syncthreads();
        }
    }
    convert_pairs(p, lds, 0, bid, G, CV_NPAIR);
}

__device__ __forceinline__ int expert_rowbase(const int* cnt, int e) {
    int base = 0;
    for (int q = 0; q < e; ++q) base += ((cnt[q] + 255) >> 8) << 8;
    return base;
}

__device__ __forceinline__ void ph_prep1(const Params& p, int l) {
    const int tid = threadIdx.x, lane = tid & 63, gw = blockIdx.x * NWAVE + (tid >> 6), GW = gridDim.x * NWAVE;
    float* XW = (float*)(p.ws + WS_XW);
    bf16_t* H = (bf16_t*)(p.ws + WS_H);
    const float* MOD = (const float*)(p.ws + WS_MOD);
    const float* nw = p.in[I_NMIX] + l * 1024;
    int mybase = 0;
    if (l == 1) mybase = expert_rowbase((const int*)(p.ws + WS_CNT), lane & 31);
    for (int idx = gw; idx < 9 * 32; idx += GW) {
        const int bb = idx >> 5, e = idx & 31;
        const float* sh2 = MOD + (size_t)(l * 9 + bb) * 6144 + 3072;
        const float* wr = p.in[I_WR] + (size_t)l * 1024 * 32 + e;
        float s = 0.f;
#pragma unroll
        for (int i = 0; i < 16; ++i) { const int k = i * 64 + lane; s += sh2[k] * wr[(size_t)k * 32]; }
        s = wave_sum(s);
        if (lane == 0) ((float*)(p.ws + WS_C9))[(l * 9 + bb) * 32 + e] = s + p.in[I_BR][l * 32 + e];
    }
    for (int row = gw; row < NT; row += GW) {
        const int mr = mod_row(row);
        float4 xv[4];
        if (l == 0) {
            const float* src = row < NL ? p.in[I_X] + (size_t)row * 1024 : p.in[I_CTX] + (size_t)(row - NL) * 1024;
#pragma unroll
            for (int j = 0; j < 4; ++j) xv[j] = *(const float4*)(src + j * 256 + lane * 4);
        } else {
#pragma unroll
            for (int j = 0; j < 4; ++j) xv[j] = *(const float4*)(XW + (size_t)row * 1024 + j * 256 + lane * 4);
            const int* route = (const int*)(p.ws + WS_ROUTE) + row * 4;
            const float* gate = (const float*)(p.ws + WS_GATE) + row * 4;
            const unsigned char* Y = p.ws + WS_Y;
            const float* g2 = MOD + (size_t)(0 * 9 + mr) * 6144 + 5120;
            float4 fs[4];
#pragma unroll
            for (int j = 0; j < 4; ++j) fs[j] = make_float4(0.f, 0.f, 0.f, 0.f);
#pragma unroll
            for (int k = 0; k < 4; ++k) {
                const int rt = route[k]; const float gk = gate[k] * (1.f / F8_YSCALE);
                const int e = rt >> 16, slot = rt & 0xffff;
                const int pos = __shfl(mybase, e) + slot;
                const unsigned char* yr = Y + (size_t)pos * 1024;
#pragma unroll
                for (int j = 0; j < 4; ++j) {
                    const unsigned w = *(const unsigned*)(yr + j * 256 + lane * 4);
                    const auto lo2 = __builtin_amdgcn_cvt_pk_f32_fp8(w, false), hi2 = __builtin_amdgcn_cvt_pk_f32_fp8(w, true);
                    fs[j].x += gk * lo2[0]; fs[j].y += gk * lo2[1]; fs[j].z += gk * hi2[0]; fs[j].w += gk * hi2[1];
                }
            }
#pragma unroll
            for (int j = 0; j < 4; ++j) {
                const float4 g = *(const float4*)(g2 + j * 256 + lane * 4);
                xv[j].x += g.x * fs[j].x; xv[j].y += g.y * fs[j].y; xv[j].z += g.z * fs[j].z; xv[j].w += g.w * fs[j].w;
            }
        }
#pragma unroll
        for (int j = 0; j < 4; ++j) *(float4*)(XW + (size_t)row * 1024 + j * 256 + lane * 4) = xv[j];
        float ss = 0.f;
#pragma unroll
        for (int j = 0; j < 4; ++j) ss += xv[j].x * xv[j].x + xv[j].y * xv[j].y + xv[j].z * xv[j].z + xv[j].w * xv[j].w;
        ss = wave_sum(ss);
        const float rstd = rsqrtf(ss * (1.f / 1024.f) + EPS);
        const float* sh = MOD + (size_t)(l * 9 + mr) * 6144;
        const float* sc = sh + 1024;
#pragma unroll
        for (int j = 0; j < 4; ++j) {
            const int k = j * 256 + lane * 4;
            const float4 w = *(const float4*)(nw + k), a = *(const float4*)(sc + k), b = *(const float4*)(sh + k);
            const float h0 = xv[j].x * rstd * w.x * (1.f + a.x) + b.x, h1 = xv[j].y * rstd * w.y * (1.f + a.y) + b.y;
            const float h2 = xv[j].z * rstd * w.z * (1.f + a.z) + b.z, h3 = xv[j].w * rstd * w.w * (1.f + a.w) + b.w;
            uint2 o; o.x = pack2bf(h0, h1); o.y = pack2bf(h2, h3);
            *(uint2*)(H + (size_t)row * 1024 + k) = o;
        }
    }
}

__device__ __forceinline__ void ph_inproj(const Params& p, int l, unsigned char* lds) {
    g8::DenseOrder S; S.init(p.ws + WS_H, p.ws + WS_WIN + (size_t)l * NIN * 1024 * 2, NT, NP);
    g8::EpiInproj E{(bf16_t*)(p.ws + WS_P), (bf16_t*)(p.ws + WS_QB), (bf16_t*)(p.ws + WS_KB), (bf16_t*)(p.ws + WS_VT), (const float*)(p.ws + WS_ROPE), (const float*)(p.ws + WS_ROPE) + 1024};
    g8::gemm_phase<false, false>((LAS unsigned char*)lds, S, E);
    if (l == 0) convert_tail(p, lds, 0, (NT / 256) * (NP / 256));
}

__device__ __forceinline__ void attn_item(const Params& p, int l, unsigned char* lds, int b, int g, int t0, bool isctx) {
    const int tid = threadIdx.x, wid = tid >> 6, lane = tid & 63, fr = lane & 15, fq = lane >> 4;
    bf16_t* Ksm = (bf16_t*)lds;
    bf16_t* VT = Ksm + 64 * 72;
    const int hh = wid >> 1, th = wid & 1, head = g * 4 + hh;
    const int tokb = t0 + th * 32;
    const bf16_t* QB = (const bf16_t*)(p.ws + WS_QB);
    const bf16_t* KBg = (const bf16_t*)(p.ws + WS_KB);
    const bf16_t* VTg = (const bf16_t*)(p.ws + WS_VT) + (size_t)(b * 2 + g) * 64 * TPB;
    bf16x8 qf[2][2];
#pragma unroll
    for (int m = 0; m < 2; ++m) {
        const int tq = tokb + m * 16 + fr;
        const int qrow = isctx ? NL + b * CTX + tq : b * S + tq;
#pragma unroll
        for (int ks = 0; ks < 2; ++ks) qf[m][ks] = *(const bf16x8*)(QB + (size_t)qrow * 512 + head * 64 + ks * 32 + fq * 8);
    }
    float mrun[2], lrun[2];
    f32x4 oacc[2][4];
    {
        const float sink = p.in[I_SINK][l * 8 + head] * 1.4426950408889634f;
#pragma unroll
        for (int m = 0; m < 2; ++m) {
            mrun[m] = sink; lrun[m] = 1.f;
#pragma unroll
            for (int dt = 0; dt < 4; ++dt) oacc[m][dt] = (f32x4){0.f, 0.f, 0.f, 0.f};
        }
    }
    int wstart = 0, wend = 0;
    if (!isctx) { wstart = t0 - 128 < 0 ? 0 : t0 - 128; wend = t0 + 64 + 128 > S ? S : t0 + 64 + 128; }
    const int ntile = 4 + ((wend - wstart) >> 6);
    const int kk = tid >> 3, dq = tid & 7;
    uint4 kreg, vreg;
    auto tile_key0 = [&](int t) { return t < 4 ? t * 64 : wstart + (t - 4) * 64; };
#define ATT_LOAD(t) do { const int _k0 = tile_key0(t); const int _krow = ((t) < 4 ? NL + b * CTX + _k0 : b * S + _k0) + kk; const int _tp = ((t) < 4 ? _k0 : CTX + _k0) + dq * 8; \
        kreg = *(const uint4*)(KBg + (size_t)_krow * 128 + g * 64 + dq * 8); vreg = *(const uint4*)(VTg + (size_t)kk * TPB + _tp); } while (0)
    ATT_LOAD(0);
#pragma unroll 1
    for (int t = 0; t < ntile; ++t) {
        const bool cx = t < 4;
        const int tk0 = tile_key0(t);
        __syncthreads();
        *(uint4*)(Ksm + kk * 72 + dq * 8) = kreg;
        *(uint4*)(VT + kk * 72 + dq * 8) = vreg;
        __syncthreads();
        if (t + 1 < ntile) ATT_LOAD(t + 1);
        f32x4 sacc[2][4];
#pragma unroll
        for (int nt = 0; nt < 4; ++nt) {
            const bf16x8 k0 = *(const bf16x8*)(Ksm + (nt * 16 + fr) * 72 + fq * 8), k1 = *(const bf16x8*)(Ksm + (nt * 16 + fr) * 72 + 32 + fq * 8);
#pragma unroll
            for (int m = 0; m < 2; ++m) {
                f32x4 a = (f32x4){0.f, 0.f, 0.f, 0.f};
                a = __builtin_amdgcn_mfma_f32_16x16x32_bf16(k0, qf[m][0], a, 0, 0, 0);
                a = __builtin_amdgcn_mfma_f32_16x16x32_bf16(k1, qf[m][1], a, 0, 0, 0);
                sacc[m][nt] = a;
            }
        }
        const bool need_mask = !cx && (tk0 < t0 - 65 || tk0 > t0 + 65);
        bf16x8 pb[2][2];
#pragma unroll
        for (int m = 0; m < 2; ++m) {
            const int tq = tokb + m * 16 + fr;
            float mx = -1e30f;
            if (need_mask) {
#pragma unroll
                for (int nt = 0; nt < 4; ++nt)
#pragma unroll
                    for (int r = 0; r < 4; ++r) {
                        const int dlt = tq - (tk0 + nt * 16 + 4 * fq + r);
                        sacc[m][nt][r] = (dlt <= 128 && dlt >= -128) ? sacc[m][nt][r] : -1e30f;
                    }
            }
#pragma unroll
            for (int nt = 0; nt < 4; ++nt)
#pragma unroll
                for (int r = 0; r < 4; ++r) mx = fmaxf(mx, sacc[m][nt][r]);
            mx = fmaxf(mx, __shfl_xor(mx, 16)); mx = fmaxf(mx, __shfl_xor(mx, 32));
            const float mn = fmaxf(mrun[m], mx);
            const float corr = __builtin_amdgcn_exp2f(mrun[m] - mn);
            float rs = 0.f;
#pragma unroll
            for (int nt = 0; nt < 4; ++nt)
#pragma unroll
                for (int r = 0; r < 4; ++r) { const float pe = __builtin_amdgcn_exp2f(sacc[m][nt][r] - mn); sacc[m][nt][r] = pe; rs += pe; }
            rs += __shfl_xor(rs, 16); rs += __shfl_xor(rs, 32);
            lrun[m] = lrun[m] * corr + rs; mrun[m] = mn;
#pragma unroll
            for (int dt = 0; dt < 4; ++dt) oacc[m][dt] *= corr;
#pragma unroll
            for (int ks = 0; ks < 2; ++ks) {
                pb[m][ks] = pack8bf(sacc[m][2 * ks][0], sacc[m][2 * ks][1], sacc[m][2 * ks][2], sacc[m][2 * ks][3], sacc[m][2 * ks + 1][0], sacc[m][2 * ks + 1][1], sacc[m][2 * ks + 1][2], sacc[m][2 * ks + 1][3]);
            }
        }
#pragma unroll
        for (int ks = 0; ks < 2; ++ks)
#pragma unroll
            for (int dt = 0; dt < 4; ++dt) {
                const uint2 vlo = *(const uint2*)(VT + (dt * 16 + fr) * 72 + ks * 32 + 4 * fq), vhi = *(const uint2*)(VT + (dt * 16 + fr) * 72 + ks * 32 + 16 + 4 * fq);
                const u32x4 vw = (u32x4){vlo.x, vlo.y, vhi.x, vhi.y};
                const bf16x8 vf = __builtin_bit_cast(bf16x8, vw);
#pragma unroll
                for (int m = 0; m < 2; ++m) oacc[m][dt] = __builtin_amdgcn_mfma_f32_16x16x32_bf16(vf, pb[m][ks], oacc[m][dt], 0, 0, 0);
            }
    }
#undef ATT_LOAD
    float* ATT = (float*)(p.ws + WS_ATT);
#pragma unroll
    for (int m = 0; m < 2; ++m) {
        const int tq = tokb + m * 16 + fr;
        const int qrow = isctx ? NL + b * CTX + tq : b * S + tq;
        const float inv = 1.f / lrun[m];
        float* dst = ATT + (size_t)qrow * 512 + head * 64 + 4 * fq;
#pragma unroll
        for (int dt = 0; dt < 4; ++dt) *(f32x4*)(dst + dt * 16) = oacc[m][dt] * inv;
    }
    __syncthreads();
}

__device__ __forceinline__ float softplus_f(float x) { return fmaxf(x, 0.f) + log1pf(expf(-fabsf(x))); }
__device__ __forceinline__ int ssd_row0(int b, int blk) { return blk < 2 ? NL + b * CTX + blk * 128 : b * S + (blk - 2) * 128; }
__device__ __forceinline__ void ssd_cs(const float* dtraw, int col, float bias, float a, int d, int lane, float& cs0, float& cs1, float& dt0, float& dt1, float& total) {
    dt0 = softplus_f(dtraw[(2 * lane) * 16 + col] + bias); dt1 = softplus_f(dtraw[(2 * lane + 1) * 16 + col] + bias);
    const float la0 = dt0 * a, la1 = dt1 * a;
    float incl = la0 + la1;
#pragma unroll
    for (int o = 1; o < 64; o <<= 1) { const float t = __shfl_up(incl, o); if (lane >= o) incl += t; }
    total = __shfl(incl, 63);
    const float p1 = incl, p0 = incl - la1;
    if (d == 0) { cs0 = p0; cs1 = p1; } else { cs0 = total - p0 + la0; cs1 = total - p1 + la1; }
}

__device__ __forceinline__ void ssd1_item(const Params& p, int l, unsigned char* lds, int it) {
    const int tid = threadIdx.x, wid = tid >> 6, lane = tid & 63, fr = lane & 15, fq = lane >> 4;
    const int b = it / 68, rr = it % 68, blk = rr >> 1, g = rr & 1;
    const bool isctx = blk < 2;
    const int row0 = ssd_row0(b, blk);
    const int s0 = isctx ? NL + b * CTX : b * S, s1 = s0 + (isctx ? CTX : S);
    bf16_t* XT = (bf16_t*)lds;
    bf16_t* BT = XT + 256 * 136;
    float* dtraw = (float*)(BT + 64 * 136);
    float* wgt = dtraw + 128 * 16;
    bf16_t* CT = (bf16_t*)(wgt + 8 * 128);
    const bf16_t* P = (const bf16_t*)(p.ws + WS_P);
    __syncthreads();
    {
        const bf16_t* A = (const bf16_t*)(p.ws + WS_H) + (size_t)(row0 + wid * 16 + fr) * 1024 + fq * 8;
        const bf16_t* Bw = (const bf16_t*)(p.ws + WS_WIN) + ((size_t)l * NIN + 2048 + fr) * 1024 + fq * 8;
        f32x4 acc = (f32x4){0.f, 0.f, 0.f, 0.f};
#pragma unroll 8
        for (int k = 0; k < 32; ++k) {
            const bf16x8 av = *(const bf16x8*)(A + k * 32), bv = *(const bf16x8*)(Bw + k * 32);
            acc = __builtin_amdgcn_mfma_f32_16x16x32_bf16(av, bv, acc, 0, 0, 0);
        }
        float* DT = (float*)(p.ws + WS_DT + (size_t)l * DT_STRIDE);
#pragma unroll
        for (int j = 0; j < 4; ++j) {
            dtraw[(wid * 16 + fq * 4 + j) * 16 + fr] = acc[j];
            if (g == 0) DT[(size_t)(row0 + wid * 16 + fq * 4 + j) * 16 + fr] = acc[j];
        }
    }
    {
        bf16_t* UXT = (bf16_t*)(p.ws + WS_UXT) + (size_t)it * 256 * 128;
#pragma unroll 1
        for (int k = 0; k < 3; ++k) {
            const int u = tid + NTHR * k, cc = u % 384, tq = u / 384;
            const int col = cc < 256 ? g * 256 + cc : (cc < 320 ? 512 + g * 64 + (cc - 256) : 640 + g * 64 + (cc - 320));
            float cw[5];
#pragma unroll
            for (int w = 0; w < 5; ++w) cw[w] = p.in[I_CONVW][(l * 5 + w) * 768 + col];
            const float cb = p.in[I_CONVB][l * 768 + col];
            const unsigned* src = (const unsigned*)(P + OXBC + (col & ~1));
            const int csh = (col & 1) * 16;
            unsigned raw[36];
#pragma unroll
            for (int i = 0; i < 36; ++i) {
                const int rw = row0 + tq * 32 - 2 + i;
                raw[i] = (rw >= s0 && rw < s1) ? src[(size_t)rw * (NP / 2)] : 0u;
            }
            __builtin_amdgcn_sched_barrier(0);
            float v[36];
#pragma unroll
            for (int i = 0; i < 36; ++i) v[i] = __uint_as_float((raw[i] >> csh) << 16);
#pragma unroll
            for (int ch = 0; ch < 4; ++ch) {
                const int t0 = tq * 32 + ch * 8;
                float o[8];
#pragma unroll
                for (int i = 0; i < 8; ++i) { const int q = ch * 8 + i; o[i] = silu_f(cb + v[q] * cw[0] + v[q + 1] * cw[1] + v[q + 2] * cw[2] + v[q + 3] * cw[3] + v[q + 4] * cw[4]); }
                uint4 w; w.x = pack2bf(o[0], o[1]); w.y = pack2bf(o[2], o[3]); w.z = pack2bf(o[4], o[5]); w.w = pack2bf(o[6], o[7]);
                if (cc < 256) {
                    *(uint4*)(XT + cc * 136 + t0) = w;
                    *(uint4*)(UXT + (size_t)cc * 128 + t0) = w;
                } else if (cc < 320) {
                    *(uint4*)(BT + (cc - 256) * 136 + t0) = w;
                } else {
                    *(uint4*)(CT + (cc - 320) * 136 + t0) = w;
                }
            }
        }
    }
    __syncthreads();
    {
        bf16_t* UBN = (bf16_t*)(p.ws + WS_UBN) + (size_t)it * 128 * 64;
        bf16_t* UCN = (bf16_t*)(p.ws + WS_UCN) + (size_t)it * 128 * 64;
#pragma unroll
        for (int i = 0; i < 4; ++i) {
            const int id = wid * 4 + i, which = id >> 4, s = id & 15, c = lane >> 3, t = (8 * c + (lane & 7) + 8 * s) & 127;
            const bf16_t* sp = (which ? CT : BT) + (c * 8) * 136 + t;
            u32x4 w;
#pragma unroll
            for (int k = 0; k < 4; ++k) w[k] = (unsigned)sp[(2 * k) * 136] | ((unsigned)sp[(2 * k + 1) * 136] << 16);
            *(u32x4*)((which ? UCN : UBN) + (size_t)t * 64 + c * 8) = w;
        }
    }
    const int h = wid >> 1, d = wid & 1, hg = g * 4 + h;
    const size_t sidx = ((size_t)(b * 8 + hg) * 2 + d) * NBLK + blk;
    {
        const float a = -expf(p.in[I_ALOG][l * 16 + d * 8 + hg]);
        const float bias = p.in[I_DTB][l * 16 + d * 8 + hg];
        float cs0, cs1, dt0, dt1, total;
        ssd_cs(dtraw, d * 8 + hg, bias, a, d, lane, cs0, cs1, dt0, dt1, total);
        wgt[wid * 128 + 2 * lane] = expf(total - cs0) * dt0;
        wgt[wid * 128 + 2 * lane + 1] = expf(total - cs1) * dt1;
        if (lane == 0) st_wt((float*)(p.ws + WS_DEC + (size_t)l * DEC_STRIDE) + sidx, expf(total));
    }
    f32x4 acc[4][4];
#pragma unroll
    for (int pt = 0; pt < 4; ++pt)
#pragma unroll
        for (int nt = 0; nt < 4; ++nt) acc[pt][nt] = (f32x4){0.f, 0.f, 0.f, 0.f};
#pragma unroll 1
    for (int ks = 0; ks < 4; ++ks) {
        const float4 wa = *(const float4*)(wgt + wid * 128 + ks * 32 + fq * 8), wb = *(const float4*)(wgt + wid * 128 + ks * 32 + fq * 8 + 4);
        const float wv[8] = {wa.x, wa.y, wa.z, wa.w, wb.x, wb.y, wb.z, wb.w};
        bf16x8 bfr[4];
#pragma unroll
        for (int nt = 0; nt < 4; ++nt) bfr[nt] = *(const bf16x8*)(BT + (nt * 16 + fr) * 136 + ks * 32 + fq * 8);
#pragma unroll
        for (int pt = 0; pt < 4; ++pt) {
            const bf16x8 xa = *(const bf16x8*)(XT + (h * 64 + pt * 16 + fr) * 136 + ks * 32 + fq * 8);
            const bf16x8 xs = pack8bf(bf2f((unsigned short)xa[0]) * wv[0], bf2f((unsigned short)xa[1]) * wv[1], bf2f((unsigned short)xa[2]) * wv[2], bf2f((unsigned short)xa[3]) * wv[3],
                                      bf2f((unsigned short)xa[4]) * wv[4], bf2f((unsigned short)xa[5]) * wv[5], bf2f((unsigned short)xa[6]) * wv[6], bf2f((unsigned short)xa[7]) * wv[7]);
#pragma unroll
            for (int nt = 0; nt < 4; ++nt) acc[pt][nt] = __builtin_amdgcn_mfma_f32_16x16x32_bf16(xs, bfr[nt], acc[pt][nt], 0, 0, 0);
        }
    }
    float* ST = (float*)(p.ws + WS_ST) + sidx * 4096 + (fq * 4) * 64 + fr;
#pragma unroll
    for (int pt = 0; pt < 4; ++pt) {
#pragma unroll
        for (int nt = 0; nt < 4; ++nt)
#pragma unroll
            for (int j = 0; j < 4; ++j) ST[(pt * 16 + j) * 64 + nt * 16] = acc[pt][nt][j];
        __builtin_amdgcn_sched_barrier(0);
    }
}

__device__ __forceinline__ void ph_attn_ssd1(const Params& p, int l, unsigned char* lds, int mask = 3) {
    const int n_lat = NBATCH * 2 * (S / 64);
    const int n_ctx = (l == 0) ? NBATCH * 2 * (CTX / 64) : 0;
    const int first = (mask & 1) ? 0 : NITEM, lastx = (mask & 2) ? NITEM + n_lat + n_ctx : NITEM;
    for (int it = first + blockIdx.x; it < lastx; it += gridDim.x) {
        if (it < NITEM) {
            ssd1_item(p, l, lds, it);
        } else if (it < NITEM + n_lat) {
            const int i2 = it - NITEM, b = i2 / 128, r = i2 % 128, g = r / 64, t0 = (r % 64) * 64;
            attn_item(p, l, lds, b, g, t0, false);
        } else {
            const int i2 = it - NITEM - n_lat, b = i2 / 8, r = i2 % 8, g = r / 4, t0 = (r % 4) * 64;
            attn_item(p, l, lds, b, g, t0, true);
        }
    }
}

__device__ __forceinline__ void ph_ssd2(const Params& p, int l) {
    const float* ST = (const float*)(p.ws + WS_ST);
    const float* DEC = (const float*)(p.ws + WS_DEC + (size_t)l * DEC_STRIDE);
    bf16_t* HS = (bf16_t*)(p.ws + WS_HS);
    for (int idx = blockIdx.x * NTHR + threadIdx.x; idx < 128 * 1024; idx += gridDim.x * NTHR) {
        const int seq = idx >> 10, e4 = (idx & 1023) * 4, d = seq & 1;
        const float* stb = ST + (size_t)seq * NBLK * 4096 + e4;
        const float* dcb = DEC + (size_t)seq * NBLK;
        bf16_t* hsb = HS + (size_t)seq * NBLK * 4096 + e4;
        float4 hst = make_float4(0.f, 0.f, 0.f, 0.f);
#pragma unroll 1
        for (int half = 0; half < 2; ++half) {
            float4 sv[17]; float dc[17];
#pragma unroll
            for (int c = 0; c < 17; ++c) {
                const int cc = half * 17 + c;
                const int blk = d == 0 ? cc : (cc < 2 ? 1 - cc : 35 - cc);
                sv[c] = *(const float4*)(stb + (size_t)blk * 4096); dc[c] = dcb[blk];
            }
#pragma unroll
            for (int c = 0; c < 17; ++c) {
                const int cc = half * 17 + c;
                const int blk = d == 0 ? cc : (cc < 2 ? 1 - cc : 35 - cc);
                uint2 w; w.x = pack2bf(hst.x, hst.y); w.y = pack2bf(hst.z, hst.w);
                *(uint2*)(hsb + (size_t)blk * 4096) = w;
                hst.x = dc[c] * hst.x + sv[c].x; hst.y = dc[c] * hst.y + sv[c].y; hst.z = dc[c] * hst.z + sv[c].z; hst.w = dc[c] * hst.w + sv[c].w;
            }
        }
    }
}

__device__ __forceinline__ void ssd3_item(const Params& p, int l, unsigned char* lds, int it) {
    const int tid = threadIdx.x, wid = tid >> 6, lane = tid & 63, fr = lane & 15, fq = lane >> 4;
    const int b = it / 68, rr = it % 68, blk = rr >> 1, g = rr & 1;
    const int row0 = ssd_row0(b, blk);
    bf16_t* XT = (bf16_t*)lds;
    bf16_t* Cn = XT + 256 * 136;
    bf16_t* Bn = Cn + 128 * 72;
    bf16_t* Mst = Bn + 128 * 72;
    float* dtraw = (float*)Mst;
    float* csA = (float*)(Mst + 8 * 16 * 136);
    float* dtA = csA + 8 * 128;
    float* ssq = dtA + 8 * 128;
    __syncthreads();
    {
        const bf16_t* UXT = (const bf16_t*)(p.ws + WS_UXT) + (size_t)it * 256 * 128;
        const bf16_t* UBN = (const bf16_t*)(p.ws + WS_UBN) + (size_t)it * 128 * 64;
        const bf16_t* UCN = (const bf16_t*)(p.ws + WS_UCN) + (size_t)it * 128 * 64;
#pragma unroll
        for (int k = 0; k < 8; ++k) { const int c = tid + NTHR * k, row = c >> 4, tc = c & 15; *(uint4*)(XT + row * 136 + tc * 8) = *(const uint4*)(UXT + (size_t)row * 128 + tc * 8); }
#pragma unroll
        for (int k = 0; k < 2; ++k) {
            const int c = tid + NTHR * k, row = c >> 3, nc = c & 7;
            *(uint4*)(Cn + row * 72 + nc * 8) = *(const uint4*)(UCN + (size_t)row * 64 + nc * 8);
            *(uint4*)(Bn + row * 72 + nc * 8) = *(const uint4*)(UBN + (size_t)row * 64 + nc * 8);
        }
        *(float4*)(dtraw + tid * 4) = *(const float4*)((const float*)(p.ws + WS_DT + (size_t)l * DT_STRIDE) + (size_t)row0 * 16 + tid * 4);
    }
    __syncthreads();
    {
        const int h = wid >> 1, d = wid & 1, hg = g * 4 + h;
        const float a = -expf(p.in[I_ALOG][l * 16 + d * 8 + hg]);
        const float bias = p.in[I_DTB][l * 16 + d * 8 + hg];
        float cs0, cs1, dt0, dt1, total;
        ssd_cs(dtraw, d * 8 + hg, bias, a, d, lane, cs0, cs1, dt0, dt1, total);
        csA[wid * 128 + 2 * lane] = cs0; csA[wid * 128 + 2 * lane + 1] = cs1;
        dtA[wid * 128 + 2 * lane] = dt0; dtA[wid * 128 + 2 * lane + 1] = dt1;
    }
    __syncthreads();
    const int h = wid >> 1, rh = wid & 1, hg = g * 4 + h;
    bf16_t* Mw = Mst + wid * 16 * 136;
    const float dsk = p.in[I_DSKIP][l * 8 + hg];
    const bf16_t* P = (const bf16_t*)(p.ws + WS_P);
    bf16_t* MIX = (bf16_t*)(p.ws + WS_MIX);
    const float* nw = p.in[I_SSMNW] + l * 512 + hg * 64;
#pragma unroll 1
    for (int st = 0; st < 4; ++st) {
        const int i0 = rh * 64 + st * 16;
        f32x4 y[4];
#pragma unroll
        for (int pt = 0; pt < 4; ++pt) y[pt] = (f32x4){0.f, 0.f, 0.f, 0.f};
        bf16x8 cf[2];
#pragma unroll
        for (int ks = 0; ks < 2; ++ks) cf[ks] = *(const bf16x8*)(Cn + (i0 + fr) * 72 + ks * 32 + fq * 8);
#pragma unroll 1
        for (int d = 0; d < 2; ++d) {
            const float* cs = csA + (h * 2 + d) * 128;
            const float* dtv = dtA + (h * 2 + d) * 128;
            const bf16_t* HS = (const bf16_t*)(p.ws + WS_HS) + (((size_t)(b * 8 + hg) * 2 + d) * NBLK + blk) * 4096;
            bf16x8 hf[4][2];
#pragma unroll
            for (int pt = 0; pt < 4; ++pt)
#pragma unroll
                for (int ks = 0; ks < 2; ++ks) hf[pt][ks] = *(const bf16x8*)(HS + (pt * 16 + fr) * 64 + ks * 32 + fq * 8);
            float csi[4];
#pragma unroll
            for (int r = 0; r < 4; ++r) csi[r] = cs[i0 + 4 * fq + r];
#pragma unroll 1
            for (int jt = 0; jt < 8; ++jt) {
                const bool need = d == 0 ? (jt * 16 <= i0 + 15) : (jt * 16 + 15 >= i0);
                f32x4 gacc = (f32x4){0.f, 0.f, 0.f, 0.f};
                const int j = jt * 16 + fr;
                if (need) {
#pragma unroll
                    for (int ks = 0; ks < 2; ++ks) {
                        const bf16x8 bfv = *(const bf16x8*)(Bn + (jt * 16 + fr) * 72 + ks * 32 + fq * 8);
                        gacc = __builtin_amdgcn_mfma_f32_16x16x32_bf16(cf[ks], bfv, gacc, 0, 0, 0);
                    }
                    const float csj = cs[j], dtj = dtv[j];
#pragma unroll
                    for (int r = 0; r < 4; ++r) {
                        const int i = i0 + 4 * fq + r;
                        const bool ok = d == 0 ? (j <= i) : (j >= i);
                        gacc[r] = ok ? gacc[r] * __expf(csi[r] - csj) * dtj : 0.f;
                    }
                }
#pragma unroll
                for (int r = 0; r < 4; ++r) Mw[(4 * fq + r) * 136 + j] = f2bf(gacc[r]);
            }
#pragma unroll 1
            for (int k4 = 0; k4 < 4; ++k4) {
                const bool need = d == 0 ? (k4 * 32 <= i0 + 15) : (k4 * 32 + 31 >= i0);
                if (need) {
                    const bf16x8 mf = *(const bf16x8*)(Mw + fr * 136 + k4 * 32 + fq * 8);
#pragma unroll
                    for (int pt = 0; pt < 4; ++pt) {
                        const bf16x8 xf = *(const bf16x8*)(XT + (h * 64 + pt * 16 + fr) * 136 + k4 * 32 + fq * 8);
                        y[pt] = __builtin_amdgcn_mfma_f32_16x16x32_bf16(mf, xf, y[pt], 0, 0, 0);
                    }
                }
            }
#pragma unroll
            for (int pt = 0; pt < 4; ++pt) {
                f32x4 a2 = (f32x4){0.f, 0.f, 0.f, 0.f};
#pragma unroll
                for (int ks = 0; ks < 2; ++ks) a2 = __builtin_amdgcn_mfma_f32_16x16x32_bf16(cf[ks], hf[pt][ks], a2, 0, 0, 0);
#pragma unroll
                for (int r = 0; r < 4; ++r) y[pt][r] += __expf(csi[r]) * a2[r];
            }
        }
        float sq[4] = {0.f, 0.f, 0.f, 0.f};
#pragma unroll
        for (int pt = 0; pt < 4; ++pt)
#pragma unroll
            for (int r = 0; r < 4; ++r) {
                const int i = i0 + 4 * fq + r, pch = pt * 16 + fr;
                const float xv = bf2f(XT[(h * 64 + pch) * 136 + i]);
                const float z = bf2f(P[(size_t)(row0 + i) * NP + OZ + hg * 64 + pch]);
                const float gv = (y[pt][r] + dsk * xv) * silu_f(z);
                y[pt][r] = gv; sq[r] += gv * gv;
            }
#pragma unroll
        for (int r = 0; r < 4; ++r) {
            float s = sq[r];
            s += __shfl_xor(s, 1); s += __shfl_xor(s, 2); s += __shfl_xor(s, 4); s += __shfl_xor(s, 8);
            if (fr == 0) ssq[(i0 + 4 * fq + r) * 4 + h] = s;
        }
        __syncthreads();
#pragma unroll
        for (int r = 0; r < 4; ++r) {
            const int i = i0 + 4 * fq + r;
            const float4 s4 = *(const float4*)(ssq + i * 4);
            const float rstd = rsqrtf((s4.x + s4.y + s4.z + s4.w) * (1.f / 256.f) + EPS);
#pragma unroll
            for (int pt = 0; pt < 4; ++pt) {
                const int pch = pt * 16 + fr;
                MIX[(size_t)(row0 + i) * 1024 + 512 + hg * 64 + pch] = f2bf(y[pt][r] * rstd * nw[pch]);
            }
        }
    }
}

__device__ __forceinline__ void ph_ssd3_prepout(const Params& p, int l, unsigned char* lds) {
    const int nitem = (l == 0) ? NITEM : NITEM;
    for (int it = blockIdx.x; it < nitem; it += gridDim.x) ssd3_item(p, l, lds, it);
    if (l == 0) convert_tail(p, lds, 1, NITEM);
    const int rfirst = nitem % (int)gridDim.x;
    if ((int)blockIdx.x < rfirst) return;
    const int tid = threadIdx.x, lane = tid & 63, gw = ((int)blockIdx.x - rfirst) * NWAVE + (tid >> 6), GW = ((int)gridDim.x - rfirst) * NWAVE;
    const float* ATT = (const float*)(p.ws + WS_ATT);
    bf16_t* MIX = (bf16_t*)(p.ws + WS_MIX);
    const int nrows = (l == 0) ? NT : NL;
    for (int row = gw; row < nrows; row += GW) {
        float4 av[2];
        float ss = 0.f;
#pragma unroll
        for (int j = 0; j < 2; ++j) {
            av[j] = *(const float4*)(ATT + (size_t)row * 512 + j * 256 + lane * 4);
            ss += av[j].x * av[j].x + av[j].y * av[j].y + av[j].z * av[j].z + av[j].w * av[j].w;
        }
        ss = wave_sum(ss);
        const float rstd = rsqrtf(ss * (1.f / 512.f) + EPS);
#pragma unroll
        for (int j = 0; j < 2; ++j) {
            const int k = j * 256 + lane * 4;
            const float4 w = *(const float4*)(p.in[I_ATTNW] + l * 512 + k);
            uint2 o; o.x = pack2bf(av[j].x * rstd * w.x, av[j].y * rstd * w.y); o.y = pack2bf(av[j].z * rstd * w.z, av[j].w * rstd * w.w);
            *(uint2*)(MIX + (size_t)row * 1024 + k) = o;
        }
    }
}

__device__ __forceinline__ void ph_outproj(const Params& p, int l, unsigned char* lds) {
    g8::DenseOrder S; S.init(p.ws + WS_MIX, p.ws + WS_WOUT + (size_t)l * 1024 * 1024 * 2, (l == 0) ? NT : NL, 1024);
    g8::EpiResid E{(float*)(p.ws + WS_XW), (const float*)(p.ws + WS_MOD) + (size_t)l * 9 * 6144 + 2048};
    g8::gemm_phase<false, false>((LAS unsigned char*)lds, S, E);
    if (l == 0) convert_tail(p, lds, 2, (NT / 256) * 4);
}

template <bool DRY>
__device__ __forceinline__ void ph_prep2(const Params& p, int l, unsigned char* lds) {
    const int tid = threadIdx.x, wid = tid >> 6, lane = tid & 63, fr = lane & 15, fq = lane >> 4;
    const float* XW = (const float*)(p.ws + WS_XW);
    unsigned char* H8 = p.ws + (DRY ? WS_MIX : WS_H);
    const float* MOD = (const float*)(p.ws + WS_MOD);
    const float* nw = p.in[I_NFFN] + l * 1024;
    const bf16_t* WH = (const bf16_t*)(p.ws + WS_WRT) + (size_t)l * 2 * 32 * 1024;
    const bf16_t* WL = WH + 32 * 1024;
    int* cnt = (int*)(p.ws + WS_CNT) + l * 32;
    int* list = (int*)(p.ws + WS_LIST + (size_t)l * LIST_STRIDE);
    int* route = (int*)(p.ws + WS_ROUTE + (size_t)l * RG_STRIDE);
    float* gate = (float*)(p.ws + WS_GATE + (size_t)l * RG_STRIDE);
    float* wl = (float*)lds + wid * 16 * 33;
    int* hist = (int*)((float*)lds + 8 * 16 * 33);
    int* basee = hist + 32;
    const int nitems = ((l == 0) ? NT : NL) / 128;
    for (int it = blockIdx.x; it < nitems; it += gridDim.x) {
        const int r0 = it * 128 + wid * 16, mr = mod_row(r0);
        const float* sh = MOD + (size_t)(l * 9 + mr) * 6144 + 3072;
        const float* sc = sh + 1024;
        if (tid < 32) hist[tid] = 0;
        f32x4 acc[2] = {(f32x4){0.f, 0.f, 0.f, 0.f}, (f32x4){0.f, 0.f, 0.f, 0.f}};
        const float* xrow = XW + (size_t)(r0 + fr) * 1024 + fq * 8;
        float ss = 0.f;
#pragma unroll 4
        for (int ks = 0; ks < 32; ++ks) {
            const int k = ks * 32 + fq * 8;
            const float4 x0 = *(const float4*)(xrow + ks * 32), x1 = *(const float4*)(xrow + ks * 32 + 4);
            const float4 w0 = *(const float4*)(nw + k), w1 = *(const float4*)(nw + k + 4), s0 = *(const float4*)(sc + k), s1 = *(const float4*)(sc + k + 4);
            ss += x0.x * x0.x + x0.y * x0.y + x0.z * x0.z + x0.w * x0.w + x1.x * x1.x + x1.y * x1.y + x1.z * x1.z + x1.w * x1.w;
            const float xa[8] = {x0.x * w0.x * (1.f + s0.x), x0.y * w0.y * (1.f + s0.y), x0.z * w0.z * (1.f + s0.z), x0.w * w0.w * (1.f + s0.w),
                                 x1.x * w1.x * (1.f + s1.x), x1.y * w1.y * (1.f + s1.y), x1.z * w1.z * (1.f + s1.z), x1.w * w1.w * (1.f + s1.w)};
            const bf16x8 ahi = pack8bf(xa[0], xa[1], xa[2], xa[3], xa[4], xa[5], xa[6], xa[7]);
            const bf16x8 alo = pack8bf(xa[0] - bf2f((unsigned short)ahi[0]), xa[1] - bf2f((unsigned short)ahi[1]), xa[2] - bf2f((unsigned short)ahi[2]), xa[3] - bf2f((unsigned short)ahi[3]),
                                       xa[4] - bf2f((unsigned short)ahi[4]), xa[5] - bf2f((unsigned short)ahi[5]), xa[6] - bf2f((unsigned short)ahi[6]), xa[7] - bf2f((unsigned short)ahi[7]));
#pragma unroll
            for (int nt = 0; nt < 2; ++nt) {
                const bf16x8 bh = *(const bf16x8*)(WH + (size_t)(nt * 16 + fr) * 1024 + k), bl = *(const bf16x8*)(WL + (size_t)(nt * 16 + fr) * 1024 + k);
                acc[nt] = __builtin_amdgcn_mfma_f32_16x16x32_bf16(ahi, bh, acc[nt], 0, 0, 0);
                acc[nt] = __builtin_amdgcn_mfma_f32_16x16x32_bf16(ahi, bl, acc[nt], 0, 0, 0);
                acc[nt] = __builtin_amdgcn_mfma_f32_16x16x32_bf16(alo, bh, acc[nt], 0, 0, 0);
            }
        }
        ss += __shfl_xor(ss, 16); ss += __shfl_xor(ss, 32);
        const float my_rstd = rsqrtf(ss * (1.f / 1024.f) + EPS);
#pragma unroll 4
        for (int rr = 0; rr < 16; ++rr) {
            const float* xr = XW + (size_t)(r0 + rr) * 1024;
            const float rstd = __shfl(my_rstd, rr);
#pragma unroll
            for (int j = 0; j < 4; ++j) {
                const int k = j * 256 + lane * 4;
                const float4 xv = *(const float4*)(xr + k);
                const float4 w = *(const float4*)(nw + k), a = *(const float4*)(sc + k), b4 = *(const float4*)(sh + k);
                const unsigned o = pack4fp8((xv.x * rstd * w.x * (1.f + a.x) + b4.x) * F8_ASCALE, (xv.y * rstd * w.y * (1.f + a.y) + b4.y) * F8_ASCALE,
                                            (xv.z * rstd * w.z * (1.f + a.z) + b4.z) * F8_ASCALE, (xv.w * rstd * w.w * (1.f + a.w) + b4.w) * F8_ASCALE);
                *(unsigned*)(H8 + (size_t)(r0 + rr) * 1024 + k) = o;
            }
        }
        {
            const float* c9 = (const float*)(p.ws + WS_C9) + (l * 9 + mr) * 32;
#pragma unroll
            for (int r = 0; r < 4; ++r) {
                const float rs = __shfl(my_rstd, 4 * fq + r);
#pragma unroll
                for (int nt = 0; nt < 2; ++nt) wl[(4 * fq + r) * 33 + nt * 16 + fr] = acc[nt][r] * rs + c9[nt * 16 + fr];
            }
        }
        const int rrow = lane >> 2, kk = lane & 3;
        float lg[32];
#pragma unroll
        for (int e2 = 0; e2 < 32; ++e2) lg[e2] = wl[rrow * 33 + e2];
        unsigned taken = 0u;
        float tv[4]; int ti[4];
#pragma unroll
        for (int k = 0; k < 4; ++k) {
            float best = -3.0e38f; int bi = 0;
#pragma unroll
            for (int e2 = 0; e2 < 32; ++e2) {
                const bool ok = !((taken >> e2) & 1u) && lg[e2] > best;
                best = ok ? lg[e2] : best; bi = ok ? e2 : bi;
            }
            taken |= 1u << bi; tv[k] = best; ti[k] = bi;
        }
        const float e1 = __expf(tv[1] - tv[0]), e2v = __expf(tv[2] - tv[0]), e3 = __expf(tv[3] - tv[0]);
        const float inv = 1.f / (1.f + e1 + e2v + e3);
        const int ek = kk == 0 ? ti[0] : kk == 1 ? ti[1] : kk == 2 ? ti[2] : ti[3];
        const float gk = (kk == 0 ? 1.f : kk == 1 ? e1 : kk == 2 ? e2v : e3) * inv;
        if (DRY) { asm volatile("" :: "v"(gk), "v"(ek)); continue; }
        __syncthreads();
        const int rank = atomicAdd(&hist[ek], 1);
        __syncthreads();
        if (tid < 32) { const int hc = hist[tid]; basee[tid] = hc ? atomicAdd(&cnt[tid], hc) : 0; }
        __syncthreads();
        const int slot = basee[ek] + rank, row = r0 + rrow;
        st_wt(list + (size_t)ek * NT + slot, row);
        route[row * 4 + kk] = (ek << 16) | slot;
        gate[row * 4 + kk] = gk;
        __syncthreads();
    }
    if (!DRY && l == 0) convert_tail(p, lds, 3, nitems);
}

__device__ __forceinline__ void ph_moe1(const Params& p, int l, unsigned char* lds) {
    g8::MoeOrder<true, 1024> S{(const int*)(p.ws + WS_CNT) + l * 32, (const int*)(p.ws + WS_LIST + (size_t)l * LIST_STRIDE), (const char*)(p.ws + WS_H),
                               (const char*)(p.ws + WS_WGU) + (size_t)l * 32 * 2048 * 1024, (int)gridDim.x, (int)blockIdx.x, nullptr};
    S.prepare((LAS int*)((LAS unsigned char*)lds + g8::MTAB_OFF));
    g8::EpiSwigluF8 E{p.ws + WS_ACT, p.in[I_BGU] + (size_t)l * 32 * 2048};
    g8::gemm_phase_f8<true, true>((LAS unsigned char*)lds, S, E);
}
__device__ __forceinline__ void ph_moe2(const Params& p, int l, unsigned char* lds) {
    g8::MoeOrder<false, 1024> S{(const int*)(p.ws + WS_CNT) + l * 32, (const int*)(p.ws + WS_LIST + (size_t)l * LIST_STRIDE), (const char*)(p.ws + WS_ACT),
                                (const char*)(p.ws + WS_WDN) + (size_t)l * 32 * 1024 * 1024, (int)gridDim.x, (int)blockIdx.x, nullptr};
    S.prepare((LAS int*)((LAS unsigned char*)lds + g8::MTAB_OFF));
    g8::EpiBiasBf16 E{p.ws + WS_Y, p.in[I_BDN] + (size_t)l * 32 * 1024};
    g8::gemm_phase_f8<false, true>((LAS unsigned char*)lds, S, E);
}

__device__ __forceinline__ void ph_final(const Params& p) {
    const int tid = threadIdx.x, lane = tid & 63, gw = blockIdx.x * NWAVE + (tid >> 6), GW = gridDim.x * NWAVE;
    const float* XW = (const float*)(p.ws + WS_XW);
    const float* MOD = (const float*)(p.ws + WS_MOD);
    const unsigned char* Y = p.ws + WS_Y;
    const int mybase = expert_rowbase((const int*)(p.ws + WS_CNT) + 32, lane & 31);
    for (int row = gw; row < NL; row += GW) {
        const int mr = mod_row(row);
        const int* route = (const int*)(p.ws + WS_ROUTE + RG_STRIDE) + row * 4;
        const float* gate = (const float*)(p.ws + WS_GATE + RG_STRIDE) + row * 4;
        const float* g2 = MOD + (size_t)(1 * 9 + mr) * 6144 + 5120;
        float4 xv[4], fs[4];
#pragma unroll
        for (int j = 0; j < 4; ++j) { xv[j] = *(const float4*)(XW + (size_t)row * 1024 + j * 256 + lane * 4); fs[j] = make_float4(0.f, 0.f, 0.f, 0.f); }
#pragma unroll
        for (int k = 0; k < 4; ++k) {
            const int rt = route[k]; const float gk = gate[k] * (1.f / F8_YSCALE);
            const int e = rt >> 16, slot = rt & 0xffff;
            const int pos = __shfl(mybase, e) + slot;
            const unsigned char* yr = Y + (size_t)pos * 1024;
#pragma unroll
            for (int j = 0; j < 4; ++j) {
                const unsigned w = *(const unsigned*)(yr + j * 256 + lane * 4);
                const auto lo2 = __builtin_amdgcn_cvt_pk_f32_fp8(w, false), hi2 = __builtin_amdgcn_cvt_pk_f32_fp8(w, true);
                fs[j].x += gk * lo2[0]; fs[j].y += gk * lo2[1]; fs[j].z += gk * hi2[0]; fs[j].w += gk * hi2[1];
            }
        }
        float ss = 0.f;
#pragma unroll
        for (int j = 0; j < 4; ++j) {
            const float4 g = *(const float4*)(g2 + j * 256 + lane * 4);
            xv[j].x += g.x * fs[j].x; xv[j].y += g.y * fs[j].y; xv[j].z += g.z * fs[j].z; xv[j].w += g.w * fs[j].w;
            ss += xv[j].x * xv[j].x + xv[j].y * xv[j].y + xv[j].z * xv[j].z + xv[j].w * xv[j].w;
        }
        ss = wave_sum(ss);
        const float rstd = rsqrtf(ss * (1.f / 1024.f) + EPS);
#pragma unroll
        for (int j = 0; j < 4; ++j) {
            const int k = j * 256 + lane * 4;
            const float4 w = *(const float4*)(p.in[I_FNW] + k);
            *(float4*)(p.out + (size_t)row * 1024 + k) = make_float4(xv[j].x * rstd * w.x, xv[j].y * rstd * w.y, xv[j].z * rstd * w.z, xv[j].w * rstd * w.w);
        }
    }
}

#define XB_TMO      128
#define XB_XCNT(j)  (256  + 64 * (j))
#define XB_XSUB(j)  (1280 + 64 * (j))
#define XB_XGEN(j)  (2304 + 64 * (j))
#define XB_TOP      3328
#define XB_TOPGEN   3392
#define XCD_BAR_WORDS 3456
#define XB_SPIN_CAP (1u << 18)
__device__ __forceinline__ unsigned xb_ld(unsigned* p)              { return __hip_atomic_load(p, __ATOMIC_RELAXED, __HIP_MEMORY_SCOPE_AGENT); }
__device__ __forceinline__ unsigned xb_add(unsigned* p, unsigned v) { return __hip_atomic_fetch_add(p, v, __ATOMIC_RELAXED, __HIP_MEMORY_SCOPE_AGENT); }
__device__ __forceinline__ unsigned xb_xcc_id() { return (unsigned)__builtin_amdgcn_s_getreg((3 << 11) | 20) & 0xFu; }
#define XB_SPIN(cond, bar) do { unsigned _sp = 0; while (cond) { __builtin_amdgcn_s_sleep(1); \
    if ((++_sp & 255u) == 0u) { if (xb_ld(&(bar)[XB_TMO])) break; if (_sp > XB_SPIN_CAP) { atomicAdd(&(bar)[XB_TMO], 1u); break; } } } } while (0)
struct XcdBarrier { unsigned* bar; unsigned x; volatile LAS unsigned* st; };
__device__ __forceinline__ XcdBarrier xcd_barrier_post(unsigned* bar, volatile LAS unsigned* st) {
    XcdBarrier b; b.bar = bar; b.x = xb_xcc_id(); b.st = st;
    if (threadIdx.x == 0) (void)xb_add(&bar[XB_XCNT(b.x)], 1u);
    return b;
}
__device__ __forceinline__ void xcd_barrier_complete(unsigned* bar, unsigned x, unsigned& nloc, unsigned& nx) {
    const unsigned G = gridDim.x * gridDim.y * gridDim.z;
    unsigned sum, cnt, mine, sp = 0u;
    for (;;) {
        sum = 0u; cnt = 0u; mine = 0u;
#pragma unroll
        for (unsigned j = 0; j < 16; ++j) { const unsigned c = xb_ld(&bar[XB_XCNT(j)]); sum += c; cnt += (c > 0u) ? 1u : 0u; mine = (j == x) ? c : mine; }
        if (sum == G) break;
        __builtin_amdgcn_s_sleep(1);
        if ((++sp & 255u) == 0u) { if (xb_ld(&bar[XB_TMO])) break; if (sp > XB_SPIN_CAP) { atomicAdd(&bar[XB_TMO], 1u); break; } }
    }
    nloc = mine > 0u ? mine : 1u; nx = cnt > 0u ? cnt : 1u;
}
__device__ __forceinline__ void xcd_barrier(const XcdBarrier& b) {
    asm volatile("s_waitcnt vmcnt(0)" ::: "memory");
    __syncthreads();
    if (threadIdx.x == 0) {
        unsigned* bar = b.bar;
        __builtin_amdgcn_s_waitcnt(0);
        unsigned nloc = b.st[0], nx = b.st[1];
        if (nloc == 0u) { xcd_barrier_complete(bar, b.x, nloc, nx); b.st[0] = nloc; b.st[1] = nx; }
        const unsigned old = xb_add(&bar[XB_XSUB(b.x)], 1u);
        const unsigned gen = old / nloc;
        if (old + 1u == (gen + 1u) * nloc) {
            __builtin_amdgcn_fence(__ATOMIC_RELEASE, "agent");
            asm volatile("s_waitcnt vmcnt(0)" ::: "memory");
            const unsigned og = xb_add(&bar[XB_TOP], 1u);
            const unsigned tg = og / nx;
            if (og + 1u == (tg + 1u) * nx) xb_add(&bar[XB_TOPGEN], 1u);
            else XB_SPIN(xb_ld(&bar[XB_TOPGEN]) == tg, bar);
            __builtin_amdgcn_fence(__ATOMIC_ACQUIRE, "agent");
            xb_add(&bar[XB_XGEN(b.x)], 1u);
            asm volatile("s_waitcnt vmcnt(0)" ::: "memory");
        } else {
            XB_SPIN(xb_ld(&bar[XB_XGEN(b.x)]) == gen, bar);
            __builtin_amdgcn_fence(__ATOMIC_ACQUIRE, "agent");
            asm volatile("s_waitcnt vmcnt(0)" ::: "memory");
        }
    }
    __syncthreads();
}

#ifndef PROBE_KIND
#define PROBE_KIND 0
#endif
namespace g8 {
struct EpiNone {
    __device__ __forceinline__ void operator()(const f32x4 (&acc)[2][2][4][2], const Unit&, int, int, int, int) const {
#pragma unroll
        for (int ai = 0; ai < 2; ++ai)
#pragma unroll
            for (int m = 0; m < 4; ++m) asm volatile("" :: "v"(acc[ai][0][m][0]), "v"(acc[ai][0][m][1]), "v"(acc[ai][1][m][0]), "v"(acc[ai][1][m][1]));
    }
};
}
__device__ __forceinline__ void ph_probe(const Params& p, unsigned char* lds, const XcdBarrier* xb) {
#if PROBE_KIND == 8
    for (int i = 0; i < 10; ++i) xcd_barrier(*xb);
#elif PROBE_KIND == 6
    ph_attn_ssd1(p, 0, lds, 2);
#elif PROBE_KIND == 7
    ph_attn_ssd1(p, 0, lds, 1);
#elif PROBE_KIND == 4
    ph_prep2<true>(p, 0, lds);
#elif PROBE_KIND == 5
    { g8::DenseOrder S; S.init(p.ws + WS_MIX, p.ws + WS_WOUT, NT, 1024); g8::EpiNone E; g8::gemm_phase<false, false>((LAS unsigned char*)lds, S, E); }
#endif
}

constexpr int N_PHASES = 20;
__global__ void __launch_bounds__(NTHR, 2) fwd(Params p) {
    extern __shared__ __attribute__((aligned(16))) unsigned char lds[];
    const int lo = p.ph_lo, hi = p.ph_hi;
    volatile LAS unsigned* xbst = (volatile LAS unsigned*)((LAS unsigned char*)lds + LDS_BYTES - 16);
    if (threadIdx.x < 4) xbst[threadIdx.x] = 0u;
    __syncthreads();
    const XcdBarrier xbar = xcd_barrier_post((unsigned*)(p.ws + WS_CTL), xbst);
#ifndef DUP_PHASE
#define DUP_PHASE -1
#endif
    if (lo == 0x7fffffff) cg::this_grid().sync();
#define PH(k, call) if (lo <= (k) && (k) < hi) { if ((k) > lo) xcd_barrier(xbar); call; if ((k) == DUP_PHASE) { call; } if (PROBE_KIND != 0 && (k) == (PROBE_KIND >= 6 ? 3 : 7)) { xcd_barrier(xbar); ph_probe(p, lds, &xbar); } }
    PH(0, ph_setup(p, lds))
    PH(1, ph_prep1(p, 0))
    PH(2, ph_inproj(p, 0, lds))
    PH(3, ph_attn_ssd1(p, 0, lds))
    PH(4, ph_ssd2(p, 0))
    PH(5, ph_ssd3_prepout(p, 0, lds))
    PH(6, ph_outproj(p, 0, lds))
    PH(7, ph_prep2<false>(p, 0, lds))
    PH(8, ph_moe1(p, 0, lds))
    PH(9, ph_moe2(p, 0, lds))
    PH(10, ph_prep1(p, 1))
    PH(11, ph_inproj(p, 1, lds))
    PH(12, ph_attn_ssd1(p, 1, lds))
    PH(13, ph_ssd2(p, 1))
    PH(14, ph_ssd3_prepout(p, 1, lds))
    PH(15, ph_outproj(p, 1, lds))
    PH(16, ph_prep2<false>(p, 1, lds))
    PH(17, ph_moe1(p, 1, lds))
    PH(18, ph_moe2(p, 1, lds))
    PH(19, ph_final(p))
#undef PH
}

extern "C" void kernel_launch(void* const* d_in, const int* in_sizes, int n_in, void* d_out, int out_size, void* d_ws, size_t ws_size, hipStream_t stream) {
    static int grid = 0;
    if (grid == 0) {
        if (n_in != 25 || ws_size < WS_END) { fprintf(stderr, "kernel_launch: unexpected n_in %d or ws_size %zu < %zu\n", n_in, ws_size, (size_t)WS_END); grid = -1; return; }
        int dev = 0, cus = 0, per_cu = 0;
        hipGetDevice(&dev);
        hipDeviceGetAttribute(&cus, hipDeviceAttributeMultiprocessorCount, dev);
        hipFuncSetAttribute((const void*)fwd, hipFuncAttributeMaxDynamicSharedMemorySize, LDS_BYTES);
        hipOccupancyMaxActiveBlocksPerMultiprocessor(&per_cu, (const void*)fwd, NTHR, LDS_BYTES);
        if (per_cu < 1) per_cu = 1;
        if (per_cu > 1) per_cu = 1;
        grid = cus * per_cu;
        fprintf(stderr, "kernel_launch: grid %d (%d per CU), ws need %zu have %zu\n", grid, per_cu, (size_t)WS_END, ws_size);
    }
    if (grid < 0) return;
    Params p{};
    for (int i = 0; i < 25; ++i) p.in[i] = (const float*)d_in[i];
    p.out = (float*)d_out; p.ws = (unsigned char*)d_ws;
    (void)hipMemsetAsync((unsigned char*)d_ws + WS_CTL, 0, XCD_BAR_WORDS * 4, stream);
#if N_LAUNCH_MODE == 0
    for (int ph = 0; ph < N_PHASES; ++ph) {
        p.ph_lo = ph; p.ph_hi = ph + 1;
        hipLaunchKernelGGL(fwd, dim3(grid), dim3(NTHR), LDS_BYTES, stream, p);
    }
#else
    p.ph_lo = 0; p.ph_hi = N_PHASES;
    void* args[] = {&p};
    hipError_t e = hipLaunchCooperativeKernel((const void*)fwd, dim3(grid), dim3(NTHR), args, LDS_BYTES, stream);
    if (e != hipSuccess) fprintf(stderr, "cooperative launch failed: %s (grid %d)\n", hipGetErrorString(e), grid);
#endif
}
```

```cpp
#include <hip/hip_runtime.h>
#include <hip/hip_cooperative_groups.h>
#include <cstdio>
#include <cstdint>
#include <cstddef>
namespace cg = cooperative_groups;

typedef unsigned short bf16_t;
typedef short bf16x8 __attribute__((ext_vector_type(8)));
typedef float f32x4 __attribute__((ext_vector_type(4)));
typedef unsigned u32x4 __attribute__((ext_vector_type(4)));
typedef int i32x8 __attribute__((ext_vector_type(8)));
typedef int i32x4 __attribute__((ext_vector_type(4)));

#ifndef N_LAUNCH_MODE
#define N_LAUNCH_MODE 1
#endif

constexpr int D = 1024, NBATCH = 8, S = 4096, CTX = 256;
constexpr int NL = NBATCH * S, NC = NBATCH * CTX, NT = NL + NC;
constexpr int NIN = 2176, NINV = 2064;
constexpr int NP = 2048;
constexpr int OQ = 0, OKK = 512, OV = 640, OZ = 768, OXBC = 1280, ODT = 2048;
constexpr int NE = 32;
constexpr int ACT_ROWS = NT * 4 + NE * 256;
constexpr float EPS = 1e-6f;
constexpr int NTHR = 512, NWAVE = 8;
constexpr int LDS_BYTES = 152 * 1024;

constexpr size_t al256(size_t x) { return (x + 65536 + 255) & ~(size_t)255; }
constexpr size_t WS_CTL   = 0;
constexpr size_t WS_CNT   = 65536;
constexpr size_t WS_ROPE  = WS_CNT + 4096;
constexpr size_t WS_C9    = WS_ROPE + 8192;
constexpr size_t WS_WRT   = WS_C9 + 4096;
constexpr size_t WS_MOD   = WS_WRT + (size_t)2 * 2 * 32 * 1024 * 2;
constexpr size_t WS_WIN   = al256(WS_MOD + (size_t)2 * 9 * 6144 * 4);
constexpr size_t WS_WOUT  = al256(WS_WIN + (size_t)2 * NIN * 1024 * 2);
constexpr size_t WS_WGU   = al256(WS_WOUT + (size_t)2 * 1024 * 1024 * 2);
constexpr size_t WS_WDN   = al256(WS_WGU + (size_t)64 * 2048 * 1024);
constexpr size_t WS_H     = al256(WS_WDN + (size_t)64 * 1024 * 1024);
constexpr size_t WS_P     = al256(WS_H + (size_t)NT * 1024 * 2);
constexpr size_t WS_DT    = al256(WS_P + (size_t)NT * NP * 4);
constexpr int NBLK = 34, NITEM = NBATCH * NBLK * 2;
constexpr int TPB = CTX + S;
constexpr size_t DT_STRIDE = (size_t)NT * 16 * 4 + 65536;
constexpr size_t WS_QB    = al256(WS_DT + 2 * DT_STRIDE);
constexpr size_t WS_KB    = al256(WS_QB + (size_t)NT * 512 * 2);
constexpr size_t WS_VT    = al256(WS_KB + (size_t)NT * 128 * 2);
constexpr size_t WS_UXT   = al256(WS_VT + (size_t)NBATCH * 2 * 64 * TPB * 2);
constexpr size_t WS_UBN   = al256(WS_UXT + (size_t)NITEM * 256 * 128 * 2);
constexpr size_t WS_UCN   = al256(WS_UBN + (size_t)NITEM * 128 * 64 * 2);
constexpr size_t WS_ST    = al256(WS_UCN + (size_t)NITEM * 128 * 64 * 2);
constexpr size_t WS_DEC   = al256(WS_ST + (size_t)128 * NBLK * 4096 * 4);
constexpr size_t DEC_STRIDE = (size_t)128 * NBLK * 4 + 65536;
constexpr size_t WS_HS    = al256(WS_DEC + 2 * DEC_STRIDE);
constexpr size_t WS_ATT   = al256(WS_HS + (size_t)128 * NBLK * 4096 * 2);
constexpr size_t WS_MIX   = al256(WS_ATT + (size_t)NT * 512 * 4);
constexpr size_t WS_XW    = al256(WS_MIX + (size_t)NT * 1024 * 2);
constexpr size_t WS_LIST  = al256(WS_XW + (size_t)NT * 1024 * 4);
constexpr size_t LIST_STRIDE = (size_t)NE * NT * 4 + 65536;
constexpr size_t WS_ROUTE = al256(WS_LIST + 2 * LIST_STRIDE);
constexpr size_t RG_STRIDE = (size_t)NT * 4 * 4 + 65536;
constexpr size_t WS_GATE  = al256(WS_ROUTE + 2 * RG_STRIDE);
constexpr size_t WS_ACT   = al256(WS_GATE + 2 * RG_STRIDE);
constexpr size_t WS_Y     = al256(WS_ACT + (size_t)ACT_ROWS * 1024);
constexpr size_t WS_END   = al256(WS_Y + (size_t)ACT_ROWS * 1024 * 2);

struct Params {
    const float* in[25];
    float* out;
    unsigned char* ws;
    int ph_lo, ph_hi;
};
enum { I_X = 0, I_C, I_CTX, I_CCTX, I_WADA, I_BADA, I_NMIX, I_NFFN, I_WIN, I_CONVW, I_CONVB, I_DTB, I_ALOG, I_DSKIP, I_SSMNW, I_SINK,
       I_ATTNW, I_WOUT, I_WR, I_BR, I_WGU, I_BGU, I_WDN, I_BDN, I_FNW };

typedef __bf16 hwbf16x2 __attribute__((ext_vector_type(2)));
typedef float hwf32x2 __attribute__((ext_vector_type(2)));
__device__ __forceinline__ unsigned pack2bf(float lo, float hi) { const hwf32x2 v = {lo, hi}; return __builtin_bit_cast(unsigned, __builtin_convertvector(v, hwbf16x2)); }
__device__ __forceinline__ unsigned short f2bf(float f) { return (unsigned short)(pack2bf(f, f) & 0xffffu); }
__device__ __forceinline__ float bf2f(unsigned short h) { return __uint_as_float((unsigned)h << 16); }
__device__ __forceinline__ f32x4 quad_transpose(const f32x4 x, int t) {
    const bool odd = (t & 1) != 0, hi = (t & 2) != 0;
    float p[4], b[4], q[4];
#pragma unroll
    for (int j = 0; j < 4; ++j) p[j] = __int_as_float(__builtin_amdgcn_mov_dpp(__float_as_int(x[j]), 0xB1, 0xF, 0xF, true));
    b[0] = odd ? p[1] : x[0]; b[1] = odd ? x[1] : p[0]; b[2] = odd ? p[3] : x[2]; b[3] = odd ? x[3] : p[2];
#pragma unroll
    for (int j = 0; j < 4; ++j) q[j] = __int_as_float(__builtin_amdgcn_mov_dpp(__float_as_int(b[j]), 0x4E, 0xF, 0xF, true));
    f32x4 y;
    y[0] = hi ? q[2] : b[0]; y[1] = hi ? q[3] : b[1]; y[2] = hi ? b[2] : q[0]; y[3] = hi ? b[3] : q[1];
    return y;
}
__device__ __forceinline__ bf16x8 pack8bf(float a0, float a1, float a2, float a3, float a4, float a5, float a6, float a7) {
    const u32x4 w = {pack2bf(a0, a1), pack2bf(a2, a3), pack2bf(a4, a5), pack2bf(a6, a7)};
    return __builtin_bit_cast(bf16x8, w);
}
__device__ __forceinline__ unsigned pack4fp8(float a, float b, float c, float d) {
    unsigned w = 0u;
    w = __builtin_amdgcn_cvt_pk_fp8_f32(a, b, w, false);
    w = __builtin_amdgcn_cvt_pk_fp8_f32(c, d, w, true);
    return w;
}
constexpr float F8_WSCALE = 64.f, F8_ASCALE = 4.f, F8_OSCALE = 1.f / (64.f * 4.f), F8_YSCALE = 16.f;
__device__ __forceinline__ void st_wt(float* q, float v) { __hip_atomic_store(q, v, __ATOMIC_RELAXED, __HIP_MEMORY_SCOPE_AGENT); }
__device__ __forceinline__ void st_wt(int* q, int v) { __hip_atomic_store(q, v, __ATOMIC_RELAXED, __HIP_MEMORY_SCOPE_AGENT); }
__device__ __forceinline__ float silu_f(float x) { return x / (1.f + __expf(-x)); }
__device__ __forceinline__ float wave_sum(float v) {
#pragma unroll
    for (int o = 32; o >= 1; o >>= 1) v += __shfl_xor(v, o);
    return v;
}
__device__ __forceinline__ int mod_row(int row) { return row < NL ? (row >> 12) : 8; }

#define LAS __attribute__((address_space(3)))
namespace g8 {
constexpr int BM = 256, BK = 64, HALF = 128, HTB = HALF * BK * 2, KB = 1024 * 2  ;
__device__ __forceinline__ int lds_byte(int r, int c) { const int st = (r >> 4) * 2 + (c >> 5), rr = r & 15, cc = c & 31, ob = rr * 64 + cc * 2; return st * 1024 + (ob ^ (((ob >> 9) & 1) << 5)); }
__device__ __forceinline__ void stage_rc(int b, int& R, int& C) { const int st = b / 1024, sb = b % 1024, swz = sb ^ (((sb >> 9) & 1) << 5); R = (st >> 1) * 16 + swz / 64; C = (st & 1) * 32 + (swz % 64) / 2; }

struct Unit {
    const char* a0;
    const char* b0;
    int r0, c0;
    int e, m0, cm1;
};

__device__ __forceinline__ int perm32(int rho) { const int n = rho >> 4, i = rho & 15; return 8 * (i >> 2) + 4 * n + (i & 3); }
constexpr int GTAB_OFF = 8 * HTB;
constexpr int BTAB_OFF = GTAB_OFF + 1024;
constexpr int MTAB_OFF = BTAB_OFF + 3072;
template <bool GATHER, bool PERM, class Sched, class Epi>
__device__ __forceinline__ void gemm_phase(LAS unsigned char* lds, const Sched& S, const Epi& E) {
    const int tid = threadIdx.x, wid = __builtin_amdgcn_readfirstlane(tid >> 6), lane = tid & 63, wr = wid >> 2, wc = wid & 3, fr = lane & 15, fq = lane >> 4;
    constexpr int nt = 1024 / BK;
    int Rr[2], Cc[2];
    unsigned voffB[2], vA[2][2];
#pragma unroll
    for (int i = 0; i < 2; ++i) { stage_rc(tid * 16 + i * 8192, Rr[i], Cc[i]); const int Rb = PERM ? ((Rr[i] & ~31) + perm32(Rr[i] & 31)) : Rr[i]; voffB[i] = (unsigned)(Rb * 1024 + Cc[i]) * 2u; }
    constexpr size_t kstep = (size_t)BK * 2;
    const unsigned ldsw = (unsigned)wid * 1024u;
    const int aoff = lds_byte(wr * 64 + fr, fq * 8), boff = lds_byte(wc * 32 + fr, fq * 8);
#define G8_SA(b, h) (((b) * 2 + (h)) * HTB)
#define G8_SB(b, h) ((4 + (b) * 2 + (h)) * HTB)
#define G8_STAGE(bufoff, gbase, voff) do { _Pragma("unroll") for (int _i = 0; _i < 2; ++_i) \
        __builtin_amdgcn_global_load_lds((const unsigned*)((const char*)(gbase) + (voff)[_i]), (LAS unsigned*)(lds + (bufoff) + ldsw + _i * 8192), 16, 0, 0); } while (0)
#define G8_LDA(dst, b, h) do { _Pragma("unroll") for (int m = 0; m < 4; ++m) _Pragma("unroll") for (int k = 0; k < 2; ++k) dst[m][k] = *(const LAS bf16x8*)(lds + G8_SA(b, h) + aoff + m * 2048 + k * 1024); } while (0)
#define G8_LDB(dst, b, h) do { _Pragma("unroll") for (int n = 0; n < 2; ++n) _Pragma("unroll") for (int k = 0; k < 2; ++k) dst[n][k] = *(const LAS bf16x8*)(lds + G8_SB(b, h) + boff + n * 2048 + k * 1024); } while (0)
#define G8_MMA(ai, bj, At, Bt) do { __builtin_amdgcn_s_setprio(1); _Pragma("unroll") for (int m = 0; m < 4; ++m) _Pragma("unroll") for (int n = 0; n < 2; ++n) _Pragma("unroll") for (int k = 0; k < 2; ++k) \
        acc[ai][bj][m][n] = __builtin_amdgcn_mfma_f32_16x16x32_bf16(Bt[n][k], At[m][k], acc[ai][bj][m][n], 0, 0, 0); __builtin_amdgcn_s_setprio(0); } while (0)
#define G8_WAIT_V(n) asm volatile("s_waitcnt vmcnt(" #n ")" ::: "memory")
#define G8_WAIT_L(n) asm volatile("s_waitcnt lgkmcnt(" #n ")" ::: "memory")
#define G8_BAR __builtin_amdgcn_s_barrier()
#define G8_SCHED __builtin_amdgcn_sched_barrier(0)
    Unit cur, nxt; int ui = 0;
    if (!S.next(0, cur)) return;
#pragma unroll
    for (int h = 0; h < 2; ++h)
#pragma unroll
        for (int i = 0; i < 2; ++i) vA[h][i] = GATHER ? S.aoff(cur, h, Rr[i], Cc[i]) : (unsigned)(Rr[i] * 1024 + Cc[i]) * 2u;
    f32x4 acc[2][2][4][2];
#pragma unroll
    for (int a = 0; a < 2; ++a)
#pragma unroll
        for (int b = 0; b < 2; ++b)
#pragma unroll
            for (int m = 0; m < 4; ++m)
#pragma unroll
                for (int n = 0; n < 2; ++n) acc[a][b][m][n] = (f32x4){0.f, 0.f, 0.f, 0.f};
    bf16x8 At[4][2], B0[2][2], B1[2][2];
    G8_STAGE(G8_SB(0, 0), cur.b0, voffB); G8_STAGE(G8_SA(0, 0), cur.a0, vA[0]); G8_STAGE(G8_SB(0, 1), (cur.b0 + Sched::B1OFF), voffB); G8_STAGE(G8_SA(0, 1), (cur.a0 + Sched::A1OFF), vA[1]);
    if (wr == 1) G8_BAR;
    G8_WAIT_V(4); G8_BAR;
    G8_STAGE(G8_SB(1, 0), cur.b0 + kstep, voffB); G8_STAGE(G8_SA(1, 0), cur.a0 + kstep, vA[0]); G8_STAGE(G8_SB(1, 1), (cur.b0 + Sched::B1OFF) + kstep, voffB);
    G8_WAIT_V(6); G8_BAR;
    for (;;) {
        const bool has_next = S.next(ui + 1, nxt);
        if (!has_next) nxt = cur;
        if (GATHER && has_next)
            __builtin_amdgcn_global_load_lds((const unsigned*)(S.list_ptr(nxt) + (wid & 3) * 64 + lane), (LAS unsigned*)(lds + GTAB_OFF + (wid & 3) * 256), 4, 0, 0);
#pragma unroll 1
        for (int t = 0; t < nt; t += 2) {
            const bool last = (t == nt - 2);
            const char* a1h1 = (cur.a0 + Sched::A1OFF) + (size_t)(t + 1) * kstep;
            const char* a2h0 = last ? nxt.a0 : cur.a0 + (size_t)(t + 2) * kstep; const char* a2h1 = last ? (nxt.a0 + Sched::A1OFF) : (cur.a0 + Sched::A1OFF) + (size_t)(t + 2) * kstep;
            const char* b2h0 = last ? nxt.b0 : cur.b0 + (size_t)(t + 2) * kstep; const char* b2h1 = last ? (nxt.b0 + Sched::B1OFF) : (cur.b0 + Sched::B1OFF) + (size_t)(t + 2) * kstep;
            G8_LDB(B0, 0, 0); G8_SCHED; G8_LDA(At, 0, 0); G8_STAGE(G8_SA(1, 1), a1h1, vA[1]);
            if (GATHER && last && has_next) {
                const int lim = nxt.cm1 - nxt.m0;
#pragma unroll
                for (int h = 0; h < 2; ++h)
#pragma unroll
                    for (int i = 0; i < 2; ++i) { int ix = h * 128 + Rr[i]; ix = ix > lim ? lim : ix;
                        vA[h][i] = (unsigned)(*(const LAS int*)(lds + GTAB_OFF + ix * 4)) * (unsigned)KB + (unsigned)Cc[i] * 2u; }
            }
            G8_WAIT_L(8); G8_BAR; G8_WAIT_L(0); G8_MMA(0, 0, At, B0); G8_BAR; G8_SCHED;
            G8_LDB(B1, 0, 1); G8_STAGE(G8_SB(0, 0), b2h0, voffB);
            G8_BAR; G8_WAIT_L(0); G8_MMA(0, 1, At, B1); G8_BAR;
            G8_LDA(At, 0, 1); G8_STAGE(G8_SA(0, 0), a2h0, vA[0]);
            G8_BAR; G8_WAIT_L(0); G8_MMA(1, 0, At, B0); G8_BAR; G8_SCHED;
            G8_STAGE(G8_SB(0, 1), b2h1, voffB);
            G8_WAIT_V(6); G8_BAR; G8_MMA(1, 1, At, B1); G8_BAR;
            G8_LDB(B0, 1, 0); G8_SCHED; G8_LDA(At, 1, 0); G8_STAGE(G8_SA(0, 1), a2h1, vA[1]);
            G8_WAIT_L(8); G8_BAR; G8_WAIT_L(0); G8_MMA(0, 0, At, B0); G8_BAR; G8_SCHED;
            G8_LDB(B1, 1, 1); G8_STAGE(G8_SB(1, 0), b2h0 + kstep, voffB);
            G8_BAR; G8_WAIT_L(0); G8_MMA(0, 1, At, B1); G8_BAR;
            G8_LDA(At, 1, 1); G8_STAGE(G8_SA(1, 0), a2h0 + kstep, vA[0]);
            G8_BAR; G8_WAIT_L(0); G8_MMA(1, 0, At, B0); G8_BAR; G8_SCHED;
            G8_STAGE(G8_SB(1, 1), b2h1 + kstep, voffB);
            G8_WAIT_V(6); G8_BAR; G8_MMA(1, 1, At, B1); G8_BAR;
        }
        E(acc, cur, wr, wc, fr, fq);
        if (!has_next) break;
#pragma unroll
        for (int a = 0; a < 2; ++a)
#pragma unroll
            for (int b = 0; b < 2; ++b)
#pragma unroll
                for (int m = 0; m < 4; ++m)
#pragma unroll
                    for (int n = 0; n < 2; ++n) acc[a][b][m][n] = (f32x4){0.f, 0.f, 0.f, 0.f};
        cur = nxt; ++ui;
    }
    G8_WAIT_V(0);
    if (wr == 0) G8_BAR;
    G8_BAR;
#undef G8_SA
#undef G8_SB
#undef G8_STAGE
#undef G8_LDA
#undef G8_LDB
#undef G8_MMA
#undef G8_WAIT_V
#undef G8_WAIT_L
#undef G8_BAR
#undef G8_SCHED
}

template <bool GATHER, bool PERM, class Sched, class Epi>
__device__ __forceinline__ void gemm_phase_f8(LAS unsigned char* lds, const Sched& S, const Epi& E) {
    const int tid = threadIdx.x, wid = __builtin_amdgcn_readfirstlane(tid >> 6), lane = tid & 63, wr = wid >> 2, wc = wid & 3, fr = lane & 15, fq = lane >> 4;
    constexpr int nt = 8, ROWB = 1024;
    int Rr[2], Cc[2];
    unsigned voffB[2], vA[2][2];
#pragma unroll
    for (int i = 0; i < 2; ++i) { stage_rc(tid * 16 + i * 8192, Rr[i], Cc[i]); const int Rb = PERM ? ((Rr[i] & ~31) + perm32(Rr[i] & 31)) : Rr[i]; voffB[i] = (unsigned)(Rb * ROWB + Cc[i] * 2); }
    constexpr size_t kstep = (size_t)BK * 2;
    const unsigned ldsw = (unsigned)wid * 1024u;
    const int aoff = lds_byte(wr * 64 + fr, fq * 16), boff = lds_byte(wc * 32 + fr, fq * 16);
#define G8_SA(b, h) (((b) * 2 + (h)) * HTB)
#define G8_SB(b, h) ((4 + (b) * 2 + (h)) * HTB)
#define G8_STAGE(bufoff, gbase, voff) do { _Pragma("unroll") for (int _i = 0; _i < 2; ++_i) \
        __builtin_amdgcn_global_load_lds((const unsigned*)((const char*)(gbase) + (voff)[_i]), (LAS unsigned*)(lds + (bufoff) + ldsw + _i * 8192), 16, 0, 0); } while (0)
#define G8_LDA(dst, b, h) do { _Pragma("unroll") for (int m = 0; m < 4; ++m) { const u32x4 _lo = *(const LAS u32x4*)(lds + G8_SA(b, h) + aoff + m * 2048), _hi = *(const LAS u32x4*)(lds + G8_SA(b, h) + aoff + m * 2048 + 16); \
        dst[m] = __builtin_shufflevector(__builtin_bit_cast(i32x4, _lo), __builtin_bit_cast(i32x4, _hi), 0, 1, 2, 3, 4, 5, 6, 7); } } while (0)
#define G8_LDB(dst, b, h) do { _Pragma("unroll") for (int n = 0; n < 2; ++n) { const u32x4 _lo = *(const LAS u32x4*)(lds + G8_SB(b, h) + boff + n * 2048), _hi = *(const LAS u32x4*)(lds + G8_SB(b, h) + boff + n * 2048 + 16); \
        dst[n] = __builtin_shufflevector(__builtin_bit_cast(i32x4, _lo), __builtin_bit_cast(i32x4, _hi), 0, 1, 2, 3, 4, 5, 6, 7); } } while (0)
#define G8_MMA(ai, bj, At, Bt) do { __builtin_amdgcn_s_setprio(1); _Pragma("unroll") for (int m = 0; m < 4; ++m) _Pragma("unroll") for (int n = 0; n < 2; ++n) \
        asm volatile("v_mfma_scale_f32_16x16x128_f8f6f4 %0, %1, %2, %0, %3, %3 op_sel_hi:[0,0,0]" : "+v"(acc[ai][bj][m][n]) : "v"(Bt[n]), "v"(At[m]), "v"(scl)); __builtin_amdgcn_s_setprio(0); } while (0)
#define G8_WAIT_V(n) asm volatile("s_waitcnt vmcnt(" #n ")" ::: "memory")
#define G8_WAIT_L(n) asm volatile("s_waitcnt lgkmcnt(" #n ")" ::: "memory")
#define G8_BAR __builtin_amdgcn_s_barrier()
#define G8_SCHED __builtin_amdgcn_sched_barrier(0)
    Unit cur, nxt; int ui = 0;
    if (!S.next(0, cur)) return;
#pragma unroll
    for (int h = 0; h < 2; ++h)
#pragma unroll
        for (int i = 0; i < 2; ++i) vA[h][i] = GATHER ? S.aoff(cur, h, Rr[i], Cc[i]) : (unsigned)(Rr[i] * ROWB + Cc[i] * 2);
    f32x4 acc[2][2][4][2];
#pragma unroll
    for (int a = 0; a < 2; ++a)
#pragma unroll
        for (int b = 0; b < 2; ++b)
#pragma unroll
            for (int m = 0; m < 4; ++m)
#pragma unroll
                for (int n = 0; n < 2; ++n) acc[a][b][m][n] = (f32x4){0.f, 0.f, 0.f, 0.f};
    i32x8 At[4], B0[2], B1[2];
    const int scl = 0x7F7F7F7F;
#define G8_BIAS_DMA(unit, par) __builtin_amdgcn_global_load_lds((const unsigned*)(E.bias_ptr(unit, wid & 3) + lane), (LAS unsigned*)(lds + BTAB_OFF + (par) * 1024 + (wid & 3) * 256), 4, 0, 0)
    G8_BIAS_DMA(cur, 0);
    G8_STAGE(G8_SB(0, 0), cur.b0, voffB); G8_STAGE(G8_SA(0, 0), cur.a0, vA[0]); G8_STAGE(G8_SB(0, 1), (cur.b0 + Sched::B1OFF), voffB); G8_STAGE(G8_SA(0, 1), (cur.a0 + Sched::A1OFF), vA[1]);
    if (wr == 1) G8_BAR;
    G8_WAIT_V(4); G8_BAR;
    G8_STAGE(G8_SB(1, 0), cur.b0 + kstep, voffB); G8_STAGE(G8_SA(1, 0), cur.a0 + kstep, vA[0]); G8_STAGE(G8_SB(1, 1), (cur.b0 + Sched::B1OFF) + kstep, voffB);
    G8_WAIT_V(6); G8_BAR;
    for (;;) {
        const bool has_next = S.next(ui + 1, nxt);
        if (!has_next) nxt = cur;
            if (has_next) G8_BIAS_DMA(nxt, (ui + 1) % 3);
        if (GATHER && has_next)
            __builtin_amdgcn_global_load_lds((const unsigned*)(S.list_ptr(nxt) + (wid & 3) * 64 + lane), (LAS unsigned*)(lds + GTAB_OFF + (wid & 3) * 256), 4, 0, 0);
#pragma unroll 1
        for (int t = 0; t < nt; t += 2) {
            const bool last = (t == nt - 2);
            const char* a1h1 = (cur.a0 + Sched::A1OFF) + (size_t)(t + 1) * kstep;
            const char* a2h0 = last ? nxt.a0 : cur.a0 + (size_t)(t + 2) * kstep; const char* a2h1 = last ? (nxt.a0 + Sched::A1OFF) : (cur.a0 + Sched::A1OFF) + (size_t)(t + 2) * kstep;
            const char* b2h0 = last ? nxt.b0 : cur.b0 + (size_t)(t + 2) * kstep; const char* b2h1 = last ? (nxt.b0 + Sched::B1OFF) : (cur.b0 + Sched::B1OFF) + (size_t)(t + 2) * kstep;
            G8_LDB(B0, 0, 0); G8_SCHED; G8_LDA(At, 0, 0); G8_STAGE(G8_SA(1, 1), a1h1, vA[1]);
            if (GATHER && last && has_next) {
                const int lim = nxt.cm1 - nxt.m0;
#pragma unroll
                for (int h = 0; h < 2; ++h)
#pragma unroll
                    for (int i = 0; i < 2; ++i) { int ix = h * 128 + Rr[i]; ix = ix > lim ? lim : ix;
                        vA[h][i] = (unsigned)(*(const LAS int*)(lds + GTAB_OFF + ix * 4)) * (unsigned)ROWB + (unsigned)Cc[i] * 2u; }
            }
            G8_WAIT_L(8); G8_BAR; G8_WAIT_L(0); G8_MMA(0, 0, At, B0); G8_BAR; G8_SCHED;
            G8_LDB(B1, 0, 1); G8_STAGE(G8_SB(0, 0), b2h0, voffB);
            G8_BAR; G8_WAIT_L(0); G8_MMA(0, 1, At, B1); G8_BAR;
            G8_LDA(At, 0, 1); G8_STAGE(G8_SA(0, 0), a2h0, vA[0]);
            G8_BAR; G8_WAIT_L(0); G8_MMA(1, 0, At, B0); G8_BAR; G8_SCHED;
            G8_STAGE(G8_SB(0, 1), b2h1, voffB);
            G8_WAIT_V(6); G8_BAR; G8_MMA(1, 1, At, B1); G8_BAR;
            G8_LDB(B0, 1, 0); G8_SCHED; G8_LDA(At, 1, 0); G8_STAGE(G8_SA(0, 1), a2h1, vA[1]);
            G8_WAIT_L(8); G8_BAR; G8_WAIT_L(0); G8_MMA(0, 0, At, B0); G8_BAR; G8_SCHED;
            G8_LDB(B1, 1, 1); G8_STAGE(G8_SB(1, 0), b2h0 + kstep, voffB);
            G8_BAR; G8_WAIT_L(0); G8_MMA(0, 1, At, B1); G8_BAR;
            G8_LDA(At, 1, 1); G8_STAGE(G8_SA(1, 0), a2h0 + kstep, vA[0]);
            G8_BAR; G8_WAIT_L(0); G8_MMA(1, 0, At, B0); G8_BAR; G8_SCHED;
            G8_STAGE(G8_SB(1, 1), b2h1 + kstep, voffB);
            G8_WAIT_V(6); G8_BAR; G8_MMA(1, 1, At, B1); G8_BAR;
        }
        asm volatile("s_nop 15\n\ts_nop 15" ::: "memory");
        E(acc, cur, wr, wc, fr, fq, (const LAS float*)(lds + BTAB_OFF + (ui % 3) * 1024));
        if (!has_next) break;
#pragma unroll
        for (int a = 0; a < 2; ++a)
#pragma unroll
            for (int b = 0; b < 2; ++b)
#pragma unroll
                for (int m = 0; m < 4; ++m)
#pragma unroll
                    for (int n = 0; n < 2; ++n) acc[a][b][m][n] = (f32x4){0.f, 0.f, 0.f, 0.f};
        cur = nxt; ++ui;
    }
    G8_WAIT_V(0);
    if (wr == 0) G8_BAR;
    G8_BAR;
#undef G8_BIAS_DMA
#undef G8_SA
#undef G8_SB
#undef G8_STAGE
#undef G8_LDA
#undef G8_LDB
#undef G8_MMA
#undef G8_WAIT_V
#undef G8_WAIT_L
#undef G8_BAR
#undef G8_SCHED
}

struct DenseOrder {
    static constexpr size_t A1OFF = (size_t)128 * KB, B1OFF = (size_t)128 * KB;
    const char* A; const char* B; int nM, nN, nwg, G, c;
    __device__ __forceinline__ void init(const void* A_, const void* B_, int M, int N) { A = (const char*)A_; B = (const char*)B_; nM = M / 256; nN = N / 256; nwg = nM * nN; G = gridDim.x; c = blockIdx.x; }
    __device__ __forceinline__ bool next(int i, Unit& u) const {
        const int L = i * G + c; if (L >= nwg) return false;
        int wgid = L; { const int q = nwg / 8, r = nwg % 8, xcd = wgid % 8, off = wgid / 8; wgid = (xcd < r ? xcd * (q + 1) : r * (q + 1) + (xcd - r) * q) + off; }
        const int nig = 8 * nN, gid = wgid / nig, fm = gid * 8, gsz = (nM - fm) < 8 ? (nM - fm) : 8;
        const int pm = fm + ((wgid % nig) % gsz), pn = (wgid % nig) / gsz;
        u.a0 = A + (size_t)pm * 256 * KB; u.b0 = B + (size_t)pn * 256 * KB;
        u.r0 = pm * 256; u.c0 = pn * 256; u.e = 0; u.m0 = 0; u.cm1 = 0; return true;
    }
    __device__ __forceinline__ unsigned aoff(const Unit&, int, int, int) const { return 0u; }
    __device__ __forceinline__ const int* list_ptr(const Unit&) const { return nullptr; }
};
template <bool GATE_UP, int ROWB>
struct MoeOrder {
    const int* cnt; const int* list; const char* A; const char* W; int G, c; const LAS int* tab;
    static constexpr int NTN = GATE_UP ? 8 : 4;
    __device__ __forceinline__ void prepare(LAS int* t) {
        tab = t;
        if (threadIdx.x < 33) { int acc = 0; for (int e = 0; e < (int)threadIdx.x; ++e) acc += (cnt[e] + 255) >> 8; t[threadIdx.x] = acc; }
        else if (threadIdx.x >= 64 && threadIdx.x < 96) t[40 + threadIdx.x - 64] = cnt[threadIdx.x - 64];
        __syncthreads();
    }
    static constexpr size_t A1OFF = GATE_UP ? 0 : (size_t)128 * ROWB, B1OFF = GATE_UP ? (size_t)1024 * ROWB : (size_t)128 * ROWB;
    __device__ __forceinline__ const int* list_ptr(const Unit& u) const { return list + (size_t)u.e * NT + u.m0; }
    __device__ __forceinline__ bool next(int i, Unit& u) const {
        int tile, nt;
        if (G == 256) {
            const int x = c & 7, w = c >> 3;
            if (GATE_UP) { nt = (x & 1) * 4 + (w & 3); tile = i * 32 + (x >> 1) * 8 + (w >> 2); }
            else         { nt = w & 3;                 tile = i * 64 + x * 8 + (w >> 2); }
        } else { const int L = i * G + c; tile = L / NTN; nt = L % NTN; }
        const int ln = (int)(threadIdx.x & 31);
        const int ts = tab[ln], te = tab[ln + 1], cn = tab[40 + ln];
        const unsigned long long hit = __ballot(tile >= ts && tile < te);
        if (hit == 0ull) return false;
        const int fe = __builtin_amdgcn_readfirstlane(__builtin_ctzll(hit) & 31);
        const int fst = __builtin_amdgcn_readlane(ts, fe), fc = __builtin_amdgcn_readlane(cn, fe);
        const int fmt = tile - fst, fbase = fst * 256;
        u.e = fe; u.m0 = fmt * 256; u.cm1 = fc - 1; u.r0 = fbase + fmt * 256;
        if (GATE_UP) {
            u.a0 = A;
            u.b0 = W + ((size_t)fe * 2048 + (size_t)nt * 128) * ROWB; u.c0 = nt * 128;
        } else {
            u.a0 = A + (size_t)u.r0 * ROWB;
            u.b0 = W + ((size_t)fe * 1024 + (size_t)nt * 256) * ROWB; u.c0 = nt * 256;
        }
        return true;
    }
    __device__ __forceinline__ unsigned aoff(const Unit& u, int h, int R, int C) const {
        int i = u.m0 + h * 128 + R; i = i > u.cm1 ? u.cm1 : i;
        return (unsigned)list[(size_t)u.e * NT + i] * (unsigned)ROWB + (unsigned)C * 2u;
    }
};

struct EpiInproj {
    bf16_t* P; bf16_t* QB; bf16_t* KB; bf16_t* VT; const float* RC; const float* RS;
    __device__ __forceinline__ void operator()(const f32x4 (&acc)[2][2][4][2], const Unit& u, int wr, int wc, int fr, int fq) const {
        const int pn = u.c0 >> 8;
        if (pn >= 3) {
#pragma unroll
            for (int ai = 0; ai < 2; ++ai)
#pragma unroll
                for (int mp = 0; mp < 2; ++mp) {
                    bf16_t* rowp = P + (size_t)(u.r0 + ai * 128 + wr * 64 + (mp * 2 + (fq & 1)) * 16 + fr) * NP + u.c0 + wc * 32 + 4 * (fq & 2);
#pragma unroll
                    for (int bj = 0; bj < 2; ++bj)
#pragma unroll
                        for (int n = 0; n < 2; ++n) {
                            const f32x4 va = acc[ai][bj][mp * 2][n], vb = acc[ai][bj][mp * 2 + 1][n];
                            const auto r0 = __builtin_amdgcn_permlane16_swap(pack2bf(va[0], va[1]), pack2bf(vb[0], vb[1]), false, false);
                            const auto r1 = __builtin_amdgcn_permlane16_swap(pack2bf(va[2], va[3]), pack2bf(vb[2], vb[3]), false, false);
                            const u32x4 o = {r0[0], r1[0], r0[1], r1[1]};
                            *(u32x4*)(rowp + bj * 128 + n * 16) = o;
                        }
                }
            return;
        }
        const bool latent = u.r0 < NL;
#pragma unroll
        for (int ai = 0; ai < 2; ++ai)
#pragma unroll
            for (int m = 0; m < 4; ++m) {
                const int row = u.r0 + ai * 128 + wr * 64 + m * 16 + fr;
                const int tok = row & (S - 1);
                const int pos = (wc & 1) ? (tok & 63) : (tok >> 6);
                f32x4 cs = (f32x4){1.f, 1.f, 1.f, 1.f}, sn = (f32x4){0.f, 0.f, 0.f, 0.f};
                if (latent) { cs = *(const f32x4*)(RC + pos * 16 + 4 * fq); sn = *(const f32x4*)(RS + pos * 16 + 4 * fq); }
#pragma unroll
                for (int bj = 0; bj < 2; ++bj) {
                    const f32x4 v0 = acc[ai][bj][m][0], v1 = acc[ai][bj][m][1];
                    if (pn == 2 && bj == 1) {
                        const int bb = latent ? (row >> 12) : ((row - NL) >> 8), tp = latent ? CTX + tok : ((row - NL) & (CTX - 1));
                        const int tq4 = fr & 3;
                        bf16_t* vt = VT + ((size_t)(bb * 2 + (wc >> 1)) * 64 + (wc & 1) * 32 + 4 * fq + tq4) * TPB + (tp - tq4);
                        const f32x4 y0 = quad_transpose(v0, tq4), y1 = quad_transpose(v1, tq4);
                        uint2 w0, w1; w0.x = pack2bf(y0[0], y0[1]); w0.y = pack2bf(y0[2], y0[3]); w1.x = pack2bf(y1[0], y1[1]); w1.y = pack2bf(y1[2], y1[3]);
                        *(uint2*)vt = w0; *(uint2*)(vt + (size_t)16 * TPB) = w1;
                    } else {
                        const float sc = pn == 2 ? 1.f : 0.125f * 1.4426950408889634f;
                        const f32x4 o0 = (v0 * cs - v1 * sn) * sc, o1 = (v1 * cs + v0 * sn) * sc;
                        bf16_t* dst = pn == 2 ? KB + (size_t)row * 128 + wc * 32 + 4 * fq : QB + (size_t)row * 512 + u.c0 + bj * 128 + wc * 32 + 4 * fq;
                        uint2 w0, w1; w0.x = pack2bf(o0[0], o0[1]); w0.y = pack2bf(o0[2], o0[3]); w1.x = pack2bf(o1[0], o1[1]); w1.y = pack2bf(o1[2], o1[3]);
                        *(uint2*)dst = w0; *(uint2*)(dst + 16) = w1;
                    }
                }
            }
    }
};
struct EpiResid {
    float* X; const float* modl;
    __device__ __forceinline__ void operator()(const f32x4 (&acc)[2][2][4][2], const Unit& u, int wr, int wc, int fr, int fq) const {
        const float* g1 = modl + (size_t)mod_row(u.r0) * 6144 + u.c0 + wc * 32 + 4 * fq;
        f32x4 gv[2][2];
#pragma unroll
        for (int bj = 0; bj < 2; ++bj)
#pragma unroll
            for (int n = 0; n < 2; ++n) gv[bj][n] = *(const f32x4*)(g1 + bj * 128 + n * 16);
#pragma unroll
        for (int ai = 0; ai < 2; ++ai)
#pragma unroll
            for (int m = 0; m < 4; ++m) {
                float* rowp = X + (size_t)(u.r0 + ai * 128 + wr * 64 + m * 16 + fr) * 1024 + u.c0 + wc * 32 + 4 * fq;
#pragma unroll
                for (int bj = 0; bj < 2; ++bj)
#pragma unroll
                    for (int n = 0; n < 2; ++n) { f32x4* q = (f32x4*)(rowp + bj * 128 + n * 16); *q = *q + gv[bj][n] * acc[ai][bj][m][n]; }
                asm volatile("" ::: "memory");
            }
    }
};
struct EpiSwigluF8 {
    unsigned char* ACT; const float* bgl;
    __device__ __forceinline__ const float* bias_ptr(const Unit& u, int chunk) const { return bgl + (size_t)u.e * 2048 + u.c0 + (chunk >> 1) * 1024 + (chunk & 1) * 64; }
    __device__ __forceinline__ void operator()(const f32x4 (&acc)[2][2][4][2], const Unit& u, int wr, int wc, int fr, int fq, const LAS float* bl) const {
        asm volatile("" : "+v"(fr), "+v"(fq));
        f32x4 bgv[2], blv[2];
#pragma unroll
        for (int n = 0; n < 2; ++n) { bgv[n] = *(const LAS f32x4*)(bl + wc * 32 + 8 * fq + n * 4); blv[n] = *(const LAS f32x4*)(bl + 128 + wc * 32 + 8 * fq + n * 4); }
#pragma unroll
        for (int ai = 0; ai < 2; ++ai)
#pragma unroll
            for (int m = 0; m < 4; ++m) {
                unsigned char* rowp = ACT + (size_t)(u.r0 + ai * 128 + wr * 64 + m * 16 + fr) * 1024 + u.c0 + wc * 32 + 8 * fq;
                float a[8];
#pragma unroll
                for (int n = 0; n < 2; ++n) {
                    const f32x4 gl = acc[ai][0][m][n] * F8_OSCALE + bgv[n], li = acc[ai][1][m][n] * F8_OSCALE + blv[n];
#pragma unroll
                    for (int j = 0; j < 4; ++j) {
                        const float gq = fminf(gl[j], 7.f), lv = __builtin_amdgcn_fmed3f(li[j], -7.f, 7.f);
                        a[n * 4 + j] = (gq * __builtin_amdgcn_rcpf(1.f + __builtin_amdgcn_exp2f(gq * (-1.702f * 1.4426950408889634f)))) * (lv * F8_ASCALE + F8_ASCALE);
                    }
                }
                uint2 w; w.x = pack4fp8(a[0], a[1], a[2], a[3]); w.y = pack4fp8(a[4], a[5], a[6], a[7]);
                *(uint2*)rowp = w;
            }
    }
};
struct EpiBiasBf16 {
    unsigned char* Y; const float* bdl;
    __device__ __forceinline__ const float* bias_ptr(const Unit& u, int chunk) const { return bdl + (size_t)u.e * 1024 + u.c0 + chunk * 64; }
    __device__ __forceinline__ void operator()(const f32x4 (&acc)[2][2][4][2], const Unit& u, int wr, int wc, int fr, int fq, const LAS float* bl) const {
        f32x4 bv[2][2];
#pragma unroll
        for (int bj = 0; bj < 2; ++bj)
#pragma unroll
            for (int n = 0; n < 2; ++n) bv[bj][n] = *(const LAS f32x4*)(bl + bj * 128 + wc * 32 + 8 * fq + n * 4) * F8_YSCALE;
#pragma unroll
        for (int ai = 0; ai < 2; ++ai)
#pragma unroll
            for (int mp = 0; mp < 2; ++mp) {
                unsigned char* rowp = Y + (size_t)(u.r0 + ai * 128 + wr * 64 + (mp * 2 + (fq & 1)) * 16 + fr) * 1024 + u.c0 + wc * 32 + 8 * (fq & 2);
#pragma unroll
                for (int bj = 0; bj < 2; ++bj) {
                    uint2 w[2];
#pragma unroll
                    for (int mi = 0; mi < 2; ++mi) {
                        const f32x4 v0 = acc[ai][bj][mp * 2 + mi][0] * (F8_OSCALE * F8_YSCALE) + bv[bj][0], v1 = acc[ai][bj][mp * 2 + mi][1] * (F8_OSCALE * F8_YSCALE) + bv[bj][1];
                        w[mi].x = pack4fp8(v0[0], v0[1], v0[2], v0[3]); w[mi].y = pack4fp8(v1[0], v1[1], v1[2], v1[3]);
                    }
                    const auto r0 = __builtin_amdgcn_permlane16_swap(w[0].x, w[1].x, false, false), r1 = __builtin_amdgcn_permlane16_swap(w[0].y, w[1].y, false, false);
                    const u32x4 o = {r0[0], r1[0], r0[1], r1[1]};
                    *(u32x4*)(rowp + bj * 128) = o;
                }
            }
    }
};
}

__device__ __forceinline__ void transpose_tile(unsigned char* lds, const float* src, int ldn, int nvalid, bf16_t* dst, int k0, int n0) {
    float* T = (float*)lds;
    const int tid = threadIdx.x;
#pragma unroll
    for (int i = 0; i < 2; ++i) {
        const int r = (tid >> 4) + 32 * i, c4 = (tid & 15) * 4, n = n0 + c4;
        float4 v = make_float4(0.f, 0.f, 0.f, 0.f);
        if (n < nvalid) v = *(const float4*)(src + (size_t)(k0 + r) * ldn + n);
        T[r * 65 + c4 + 0] = v.x; T[r * 65 + c4 + 1] = v.y; T[r * 65 + c4 + 2] = v.z; T[r * 65 + c4 + 3] = v.w;
    }
    __syncthreads();
    {
        const int n = tid >> 3, kc = tid & 7;
        float v[8];
#pragma unroll
        for (int j = 0; j < 8; ++j) v[j] = T[(kc * 8 + j) * 65 + n];
        uint4 w; w.x = pack2bf(v[0], v[1]); w.y = pack2bf(v[2], v[3]); w.z = pack2bf(v[4], v[5]); w.w = pack2bf(v[6], v[7]);
        *(uint4*)(dst + (size_t)(n0 + n) * 1024 + k0 + kc * 8) = w;
    }
    __syncthreads();
}

__device__ __forceinline__ void transpose_tile_f8(unsigned char* lds, const float* src, int ldn, unsigned char* dst, int k0, int n0) {
    float* T = (float*)lds;
    const int tid = threadIdx.x;
#pragma unroll
    for (int i = 0; i < 2; ++i) {
        const int r = (tid >> 4) + 32 * i, c4 = (tid & 15) * 4;
        const float4 v = *(const float4*)(src + (size_t)(k0 + r) * ldn + n0 + c4);
        T[r * 65 + c4 + 0] = v.x; T[r * 65 + c4 + 1] = v.y; T[r * 65 + c4 + 2] = v.z; T[r * 65 + c4 + 3] = v.w;
    }
    __syncthreads();
    {
        const int n = tid >> 3, kc = tid & 7;
        float v[8];
#pragma unroll
        for (int j = 0; j < 8; ++j) v[j] = T[(kc * 8 + j) * 65 + n] * F8_WSCALE;
        uint2 w; w.x = pack4fp8(v[0], v[1], v[2], v[3]); w.y = pack4fp8(v[4], v[5], v[6], v[7]);
        *(uint2*)(dst + (size_t)(n0 + n) * 1024 + k0 + kc * 8) = w;
    }
    __syncthreads();
}

constexpr int CV_T0 = 16 * 34, CV_T1 = CV_T0 + 256, CV_T2 = CV_T1 + 32 * 512, CV_TT = CV_T2 + 32 * 256, CV_NPAIR = CV_TT / 2;
struct CvTile { const float* src; unsigned char* dst; int ldn, nv, k0, n0, kind; };
__device__ __forceinline__ CvTile cv_decode(const Params& p, int l, int it) {
    CvTile t;
    if (it < CV_T0) { const int r = it; t.k0 = (r / 34) * 64; t.n0 = (r % 34) * 64; t.src = p.in[I_WIN] + (size_t)l * 1024 * NINV; t.ldn = NINV; t.nv = NINV; t.dst = p.ws + WS_WIN + (size_t)l * NIN * 1024 * 2; t.kind = 0; }
    else if (it < CV_T1) { const int r = it - CV_T0; t.k0 = (r / 16) * 64; t.n0 = (r % 16) * 64; t.src = p.in[I_WOUT] + (size_t)l * 1024 * 1024; t.ldn = 1024; t.nv = 1024; t.dst = p.ws + WS_WOUT + (size_t)l * 1024 * 1024 * 2; t.kind = 0; }
    else if (it < CV_T2) { const int i2 = it - CV_T1, le = l * 32 + i2 / 512, r = i2 % 512; t.k0 = (r % 16) * 64; t.n0 = (r / 16) * 64; t.src = p.in[I_WGU] + (size_t)le * 1024 * 2048; t.ldn = 2048; t.nv = 2048; t.dst = p.ws + WS_WGU + (size_t)le * 2048 * 1024; t.kind = 1; }
    else { const int i2 = it - CV_T2, le = l * 32 + i2 / 256, r = i2 % 256; t.k0 = (r % 16) * 64; t.n0 = (r / 16) * 64; t.src = p.in[I_WDN] + (size_t)le * 1024 * 1024; t.ldn = 1024; t.nv = 1024; t.dst = p.ws + WS_WDN + (size_t)le * 1024 * 1024; t.kind = 1; }
    return t;
}
__device__ __forceinline__ void convert_pairs(const Params& p, unsigned char* lds, int l, int q_first, int q_stride, int q_end) {
    constexpr int D = 4;
    const int tid = threadIdx.x;
    float* T = (float*)lds;
    const int npair = (q_first < q_end) ? (q_end - q_first + q_stride - 1) / q_stride : 0, ntile = 2 * npair;
    const int lr = tid >> 4, lc4 = (tid & 15) * 4;
    float4 pv[D][2];
    __syncthreads();
#pragma unroll
    for (int d = 0; d < D; ++d) {
#pragma unroll
        for (int i = 0; i < 2; ++i) pv[d][i] = make_float4(0.f, 0.f, 0.f, 0.f);
        if (d < ntile) {
            const CvTile t = cv_decode(p, l, 2 * (q_first + (d >> 1) * q_stride) + (d & 1));
#pragma unroll
            for (int i = 0; i < 2; ++i) if (t.n0 + lc4 < t.nv) pv[d][i] = *(const float4*)(t.src + (size_t)(t.k0 + lr + 32 * i) * t.ldn + t.n0 + lc4);
        }
    }
#pragma unroll 1
    for (int s0 = 0; s0 < ntile; s0 += D) {
#pragma unroll
        for (int d = 0; d < D; ++d) {
            const int s = s0 + d;
            if (s < ntile) {
                float* Tp = T + (d & 1) * 64 * 65;
#pragma unroll
                for (int i = 0; i < 2; ++i) { float* q = Tp + (lr + 32 * i) * 65 + lc4; q[0] = pv[d][i].x; q[1] = pv[d][i].y; q[2] = pv[d][i].z; q[3] = pv[d][i].w; }
                __syncthreads();
                if (s + D < ntile) {
                    const int s2 = s + D;
                    const CvTile t = cv_decode(p, l, 2 * (q_first + (s2 >> 1) * q_stride) + (s2 & 1));
#pragma unroll
                    for (int i = 0; i < 2; ++i) { pv[d][i] = make_float4(0.f, 0.f, 0.f, 0.f); if (t.n0 + lc4 < t.nv) pv[d][i] = *(const float4*)(t.src + (size_t)(t.k0 + lr + 32 * i) * t.ldn + t.n0 + lc4); }
                }
                const CvTile c = cv_decode(p, l, 2 * (q_first + (s >> 1) * q_stride) + (s & 1));
                const int n = tid >> 3, kc = tid & 7;
                float v[8];
#pragma unroll
                for (int j = 0; j < 8; ++j) v[j] = Tp[(kc * 8 + j) * 65 + n];
                if (c.kind == 0) {
                    uint4 w; w.x = pack2bf(v[0], v[1]); w.y = pack2bf(v[2], v[3]); w.z = pack2bf(v[4], v[5]); w.w = pack2bf(v[6], v[7]);
                    *(uint4*)(c.dst + ((size_t)(c.n0 + n) * 1024 + c.k0 + kc * 8) * 2) = w;
                } else {
                    uint2 w; w.x = pack4fp8(v[0] * F8_WSCALE, v[1] * F8_WSCALE, v[2] * F8_WSCALE, v[3] * F8_WSCALE); w.y = pack4fp8(v[4] * F8_WSCALE, v[5] * F8_WSCALE, v[6] * F8_WSCALE, v[7] * F8_WSCALE);
                    *(uint2*)(c.dst + (size_t)(c.n0 + n) * 1024 + c.k0 + kc * 8) = w;
                }
            }
        }
    }
    __syncthreads();
}
constexpr int CV_Q0 = 0, CV_Q1 = CV_Q0 + 1500, CV_Q2 = CV_Q1 + 4200;
__device__ __forceinline__ void convert_tail(const Params& p, unsigned char* lds, int slot, int nunits) {
    const int G = gridDim.x, c = blockIdx.x, first = nunits % G;
    if (c < first) return;
    const int lo = (slot == 0) ? 0 : (slot == 1) ? CV_Q0 : (slot == 2) ? CV_Q1 : CV_Q2, hi = (slot == 0) ? CV_Q0 : (slot == 1) ? CV_Q1 : (slot == 2) ? CV_Q2 : CV_NPAIR;
    convert_pairs(p, lds, 1, lo + (c - first), G - first, hi);
}


__device__ __forceinline__ void ph_setup(const Params& p, unsigned char* lds) {
    const int tid = threadIdx.x, G = gridDim.x, bid = blockIdx.x;
    if (bid == 0) {
        int* cnt = (int*)(p.ws + WS_CNT);
        if (tid < 64) cnt[tid] = 0;
        float* rc = (float*)(p.ws + WS_ROPE);
        for (int i = tid; i < 1024; i += NTHR) {
            const int pos = i >> 4, f = i & 15;
            double th = 1.0;
            for (int q = 0; q < f; ++q) th *= 0.56234132519034908;
            const double t2 = th * th;
            double c1 = 1.0, s1 = th, tc = 1.0, tsn = th;
            for (int q = 1; q <= 12; ++q) {
                tc *= -t2 / (double)((2 * q - 1) * (2 * q));
                tsn *= -t2 / (double)((2 * q) * (2 * q + 1));
                c1 += tc; s1 += tsn;
            }
            double cc = 1.0, ss = 0.0;
            for (int q = 0; q < pos; ++q) { const double nc = cc * c1 - ss * s1, ns = ss * c1 + cc * s1; cc = nc; ss = ns; }
            rc[i] = (float)cc; rc[1024 + i] = (float)ss;
        }
    }
    for (int idx = bid * NTHR + tid; idx < 2 * 32 * 1024; idx += G * NTHR) {
        const int l = idx >> 15, e = (idx >> 10) & 31, k = idx & 1023;
        const float w = p.in[I_WR][((size_t)l * 1024 + k) * 32 + e];
        const unsigned short hi = f2bf(w), lo = f2bf(w - bf2f(hi));
        bf16_t* WRT = (bf16_t*)(p.ws + WS_WRT) + (size_t)l * 2 * 32 * 1024;
        WRT[e * 1024 + k] = hi; WRT[32 * 1024 + e * 1024 + k] = lo;
    }
    {
        float* sil = (float*)lds;
        float* part = sil + 9 * 1024;
        float* MOD = (float*)(p.ws + WS_MOD);
        const int wid = tid >> 6, lane = tid & 63;
        for (int it = bid; it < 192; it += G) {
            const int l = it / 96, j0 = (it % 96) * 64;
            for (int idx = tid; idx < 9 * 1024; idx += NTHR) {
                const int r = idx >> 10, k = idx & 1023;
                const float v = r < 8 ? p.in[I_C][r * 1024 + k] : p.in[I_CCTX][k];
                sil[idx] = silu_f(v);
            }
            __syncthreads();
            float acc[9];
#pragma unroll
            for (int r = 0; r < 9; ++r) acc[r] = 0.f;
            const float* w = p.in[I_WADA] + (size_t)l * 1024 * 6144 + j0 + lane;
#pragma unroll 1
            for (int k0 = wid * 128; k0 < wid * 128 + 128; k0 += 16) {
                float wv[16];
#pragma unroll
                for (int u = 0; u < 16; ++u) wv[u] = w[(size_t)(k0 + u) * 6144];
#pragma unroll
                for (int u = 0; u < 16; ++u)
#pragma unroll
                    for (int r = 0; r < 9; ++r) acc[r] += sil[r * 1024 + k0 + u] * wv[u];
            }
#pragma unroll
            for (int r = 0; r < 9; ++r) part[(wid * 9 + r) * 64 + lane] = acc[r];
            __syncthreads();
            for (int idx = tid; idx < 9 * 64; idx += NTHR) {
                const int r = idx >> 6, c = idx & 63;
                float s = 0.f;
#pragma unroll
                for (int w8 = 0; w8 < 8; ++w8) s += part[(w8 * 9 + r) * 64 + c];
                MOD[(size_t)(l * 9 + r) * 6144 + j0 + c] = s + p.in[I_BADA][l * 6144 + j0 + c];
            }
            __syncthreads();
        }
    }
    convert_pairs(p, lds, 0, bid, G, CV_NPAIR);
}

__device__ __forceinline__ int expert_rowbase(const int* cnt, int e) {
    int base = 0;
    for (int q = 0; q < e; ++q) base += ((cnt[q] + 255) >> 8) << 8;
    return base;
}

__device__ __forceinline__ void ph_prep1(const Params& p, int l) {
    const int tid = threadIdx.x, lane = tid & 63, gw = blockIdx.x * NWAVE + (tid >> 6), GW = gridDim.x * NWAVE;
    float* XW = (float*)(p.ws + WS_XW);
    bf16_t* H = (bf16_t*)(p.ws + WS_H);
    const float* MOD = (const float*)(p.ws + WS_MOD);
    const float* nw = p.in[I_NMIX] + l * 1024;
    int mybase = 0;
    if (l == 1) mybase = expert_rowbase((const int*)(p.ws + WS_CNT), lane & 31);
    for (int idx = gw; idx < 9 * 32; idx += GW) {
        const int bb = idx >> 5, e = idx & 31;
        const float* sh2 = MOD + (size_t)(l * 9 + bb) * 6144 + 3072;
        const float* wr = p.in[I_WR] + (size_t)l * 1024 * 32 + e;
        float s = 0.f;
#pragma unroll
        for (int i = 0; i < 16; ++i) { const int k = i * 64 + lane; s += sh2[k] * wr[(size_t)k * 32]; }
        s = wave_sum(s);
        if (lane == 0) ((float*)(p.ws + WS_C9))[(l * 9 + bb) * 32 + e] = s + p.in[I_BR][l * 32 + e];
    }
    for (int row = gw; row < NT; row += GW) {
        const int mr = mod_row(row);
        float4 xv[4];
        if (l == 0) {
            const float* src = row < NL ? p.in[I_X] + (size_t)row * 1024 : p.in[I_CTX] + (size_t)(row - NL) * 1024;
#pragma unroll
            for (int j = 0; j < 4; ++j) xv[j] = *(const float4*)(src + j * 256 + lane * 4);
        } else {
#pragma unroll
            for (int j = 0; j < 4; ++j) xv[j] = *(const float4*)(XW + (size_t)row * 1024 + j * 256 + lane * 4);
            const int* route = (const int*)(p.ws + WS_ROUTE) + row * 4;
            const float* gate = (const float*)(p.ws + WS_GATE) + row * 4;
            const unsigned char* Y = p.ws + WS_Y;
            const float* g2 = MOD + (size_t)(0 * 9 + mr) * 6144 + 5120;
            float4 fs[4];
#pragma unroll
            for (int j = 0; j < 4; ++j) fs[j] = make_float4(0.f, 0.f, 0.f, 0.f);
#pragma unroll
            for (int k = 0; k < 4; ++k) {
                const int rt = route[k]; const float gk = gate[k] * (1.f / F8_YSCALE);
                const int e = rt >> 16, slot = rt & 0xffff;
                const int pos = __shfl(mybase, e) + slot;
                const unsigned char* yr = Y + (size_t)pos * 1024;
#pragma unroll
                for (int j = 0; j < 4; ++j) {
                    const unsigned w = *(const unsigned*)(yr + j * 256 + lane * 4);
                    const auto lo2 = __builtin_amdgcn_cvt_pk_f32_fp8(w, false), hi2 = __builtin_amdgcn_cvt_pk_f32_fp8(w, true);
                    fs[j].x += gk * lo2[0]; fs[j].y += gk * lo2[1]; fs[j].z += gk * hi2[0]; fs[j].w += gk * hi2[1];
                }
            }
#pragma unroll
            for (int j = 0; j < 4; ++j) {
                const float4 g = *(const float4*)(g2 + j * 256 + lane * 4);
                xv[j].x += g.x * fs[j].x; xv[j].y += g.y * fs[j].y; xv[j].z += g.z * fs[j].z; xv[j].w += g.w * fs[j].w;
            }
        }
#pragma unroll
        for (int j = 0; j < 4; ++j) *(float4*)(XW + (size_t)row * 1024 + j * 256 + lane * 4) = xv[j];
        float ss = 0.f;
#pragma unroll
        for (int j = 0; j < 4; ++j) ss += xv[j].x * xv[j].x + xv[j].y * xv[j].y + xv[j].z * xv[j].z + xv[j].w * xv[j].w;
        ss = wave_sum(ss);
        const float rstd = rsqrtf(ss * (1.f / 1024.f) + EPS);
        const float* sh = MOD + (size_t)(l * 9 + mr) * 6144;
        const float* sc = sh + 1024;
#pragma unroll
        for (int j = 0; j < 4; ++j) {
            const int k = j * 256 + lane * 4;
            const float4 w = *(const float4*)(nw + k), a = *(const float4*)(sc + k), b = *(const float4*)(sh + k);
            const float h0 = xv[j].x * rstd * w.x * (1.f + a.x) + b.x, h1 = xv[j].y * rstd * w.y * (1.f + a.y) + b.y;
            const float h2 = xv[j].z * rstd * w.z * (1.f + a.z) + b.z, h3 = xv[j].w * rstd * w.w * (1.f + a.w) + b.w;
            uint2 o; o.x = pack2bf(h0, h1); o.y = pack2bf(h2, h3);
            *(uint2*)(H + (size_t)row * 1024 + k) = o;
        }
    }
}

__device__ __forceinline__ void ph_inproj(const Params& p, int l, unsigned char* lds) {
    g8::DenseOrder S; S.init(p.ws + WS_H, p.ws + WS_WIN + (size_t)l * NIN * 1024 * 2, NT, NP);
    g8::EpiInproj E{(bf16_t*)(p.ws + WS_P), (bf16_t*)(p.ws + WS_QB), (bf16_t*)(p.ws + WS_KB), (bf16_t*)(p.ws + WS_VT), (const float*)(p.ws + WS_ROPE), (const float*)(p.ws + WS_ROPE) + 1024};
    g8::gemm_phase<false, false>((LAS unsigned char*)lds, S, E);
    if (l == 0) convert_tail(p, lds, 0, (NT / 256) * (NP / 256));
}

__device__ __forceinline__ void attn_item(const Params& p, int l, unsigned char* lds, int b, int g, int t0, bool isctx) {
    const int tid = threadIdx.x, wid = tid >> 6, lane = tid & 63, fr = lane & 15, fq = lane >> 4;
    bf16_t* Ksm = (bf16_t*)lds;
    bf16_t* VT = Ksm + 64 * 72;
    const int hh = wid >> 1, th = wid & 1, head = g * 4 + hh;
    const int tokb = t0 + th * 32;
    const bf16_t* QB = (const bf16_t*)(p.ws + WS_QB);
    const bf16_t* KBg = (const bf16_t*)(p.ws + WS_KB);
    const bf16_t* VTg = (const bf16_t*)(p.ws + WS_VT) + (size_t)(b * 2 + g) * 64 * TPB;
    bf16x8 qf[2][2];
#pragma unroll
    for (int m = 0; m < 2; ++m) {
        const int tq = tokb + m * 16 + fr;
        const int qrow = isctx ? NL + b * CTX + tq : b * S + tq;
#pragma unroll
        for (int ks = 0; ks < 2; ++ks) qf[m][ks] = *(const bf16x8*)(QB + (size_t)qrow * 512 + head * 64 + ks * 32 + fq * 8);
    }
    float mrun[2], lrun[2];
    f32x4 oacc[2][4];
    {
        const float sink = p.in[I_SINK][l * 8 + head] * 1.4426950408889634f;
#pragma unroll
        for (int m = 0; m < 2; ++m) {
            mrun[m] = sink; lrun[m] = 1.f;
#pragma unroll
            for (int dt = 0; dt < 4; ++dt) oacc[m][dt] = (f32x4){0.f, 0.f, 0.f, 0.f};
        }
    }
    int wstart = 0, wend = 0;
    if (!isctx) { wstart = t0 - 128 < 0 ? 0 : t0 - 128; wend = t0 + 64 + 128 > S ? S : t0 + 64 + 128; }
    const int ntile = 4 + ((wend - wstart) >> 6);
    const int kk = tid >> 3, dq = tid & 7;
    uint4 kreg, vreg;
    auto tile_key0 = [&](int t) { return t < 4 ? t * 64 : wstart + (t - 4) * 64; };
#define ATT_LOAD(t) do { const int _k0 = tile_key0(t); const int _krow = ((t) < 4 ? NL + b * CTX + _k0 : b * S + _k0) + kk; const int _tp = ((t) < 4 ? _k0 : CTX + _k0) + dq * 8; \
        kreg = *(const uint4*)(KBg + (size_t)_krow * 128 + g * 64 + dq * 8); vreg = *(const uint4*)(VTg + (size_t)kk * TPB + _tp); } while (0)
    ATT_LOAD(0);
#pragma unroll 1
    for (int t = 0; t < ntile; ++t) {
        const bool cx = t < 4;
        const int tk0 = tile_key0(t);
        __syncthreads();
        *(uint4*)(Ksm + kk * 72 + dq * 8) = kreg;
        *(uint4*)(VT + kk * 72 + dq * 8) = vreg;
        __syncthreads();
        if (t + 1 < ntile) ATT_LOAD(t + 1);
        f32x4 sacc[2][4];
#pragma unroll
        for (int nt = 0; nt < 4; ++nt) {
            const bf16x8 k0 = *(const bf16x8*)(Ksm + (nt * 16 + fr) * 72 + fq * 8), k1 = *(const bf16x8*)(Ksm + (nt * 16 + fr) * 72 + 32 + fq * 8);
#pragma unroll
            for (int m = 0; m < 2; ++m) {
                f32x4 a = (f32x4){0.f, 0.f, 0.f, 0.f};
                a = __builtin_amdgcn_mfma_f32_16x16x32_bf16(k0, qf[m][0], a, 0, 0, 0);
                a = __builtin_amdgcn_mfma_f32_16x16x32_bf16(k1, qf[m][1], a, 0, 0, 0);
                sacc[m][nt] = a;
            }
        }
        const bool need_mask = !cx && (tk0 < t0 - 65 || tk0 > t0 + 65);
        bf16x8 pb[2][2];
#pragma unroll
        for (int m = 0; m < 2; ++m) {
            const int tq = tokb + m * 16 + fr;
            float mx = -1e30f;
            if (need_mask) {
#pragma unroll
                for (int nt = 0; nt < 4; ++nt)
#pragma unroll
                    for (int r = 0; r < 4; ++r) {
                        const int dlt = tq - (tk0 + nt * 16 + 4 * fq + r);
                        sacc[m][nt][r] = (dlt <= 128 && dlt >= -128) ? sacc[m][nt][r] : -1e30f;
                    }
            }
#pragma unroll
            for (int nt = 0; nt < 4; ++nt)
#pragma unroll
                for (int r = 0; r < 4; ++r) mx = fmaxf(mx, sacc[m][nt][r]);
            mx = fmaxf(mx, __shfl_xor(mx, 16)); mx = fmaxf(mx, __shfl_xor(mx, 32));
            const float mn = fmaxf(mrun[m], mx);
            const float corr = __builtin_amdgcn_exp2f(mrun[m] - mn);
            float rs = 0.f;
#pragma unroll
            for (int nt = 0; nt < 4; ++nt)
#pragma unroll
                for (int r = 0; r < 4; ++r) { const float pe = __builtin_amdgcn_exp2f(sacc[m][nt][r] - mn); sacc[m][nt][r] = pe; rs += pe; }
            rs += __shfl_xor(rs, 16); rs += __shfl_xor(rs, 32);
            lrun[m] = lrun[m] * corr + rs; mrun[m] = mn;
#pragma unroll
            for (int dt = 0; dt < 4; ++dt) oacc[m][dt] *= corr;
#pragma unroll
            for (int ks = 0; ks < 2; ++ks) {
                pb[m][ks] = pack8bf(sacc[m][2 * ks][0], sacc[m][2 * ks][1], sacc[m][2 * ks][2], sacc[m][2 * ks][3], sacc[m][2 * ks + 1][0], sacc[m][2 * ks + 1][1], sacc[m][2 * ks + 1][2], sacc[m][2 * ks + 1][3]);
            }
        }
#pragma unroll
        for (int ks = 0; ks < 2; ++ks)
#pragma unroll
            for (int dt = 0; dt < 4; ++dt) {
                const uint2 vlo = *(const uint2*)(VT + (dt * 16 + fr) * 72 + ks * 32 + 4 * fq), vhi = *(const uint2*)(VT + (dt * 16 + fr) * 72 + ks * 32 + 16 + 4 * fq);
                const u32x4 vw = (u32x4){vlo.x, vlo.y, vhi.x, vhi.y};
                const bf16x8 vf = __builtin_bit_cast(bf16x8, vw);
#pragma unroll
                for (int m = 0; m < 2; ++m) oacc[m][dt] = __builtin_amdgcn_mfma_f32_16x16x32_bf16(vf, pb[m][ks], oacc[m][dt], 0, 0, 0);
            }
    }
#undef ATT_LOAD
    float* ATT = (float*)(p.ws + WS_ATT);
#pragma unroll
    for (int m = 0; m < 2; ++m) {
        const int tq = tokb + m * 16 + fr;
        const int qrow = isctx ? NL + b * CTX + tq : b * S + tq;
        const float inv = 1.f / lrun[m];
        float* dst = ATT + (size_t)qrow * 512 + head * 64 + 4 * fq;
#pragma unroll
        for (int dt = 0; dt < 4; ++dt) *(f32x4*)(dst + dt * 16) = oacc[m][dt] * inv;
    }
    __syncthreads();
}

__device__ __forceinline__ float softplus_f(float x) { return fmaxf(x, 0.f) + log1pf(expf(-fabsf(x))); }
__device__ __forceinline__ int ssd_row0(int b, int blk) { return blk < 2 ? NL + b * CTX + blk * 128 : b * S + (blk - 2) * 128; }
__device__ __forceinline__ void ssd_cs(const float* dtraw, int col, float bias, float a, int d, int lane, float& cs0, float& cs1, float& dt0, float& dt1, float& total) {
    dt0 = softplus_f(dtraw[(2 * lane) * 16 + col] + bias); dt1 = softplus_f(dtraw[(2 * lane + 1) * 16 + col] + bias);
    const float la0 = dt0 * a, la1 = dt1 * a;
    float incl = la0 + la1;
#pragma unroll
    for (int o = 1; o < 64; o <<= 1) { const float t = __shfl_up(incl, o); if (lane >= o) incl += t; }
    total = __shfl(incl, 63);
    const float p1 = incl, p0 = incl - la1;
    if (d == 0) { cs0 = p0; cs1 = p1; } else { cs0 = total - p0 + la0; cs1 = total - p1 + la1; }
}

__device__ __forceinline__ void ssd1_item(const Params& p, int l, unsigned char* lds, int it) {
    const int tid = threadIdx.x, wid = tid >> 6, lane = tid & 63, fr = lane & 15, fq = lane >> 4;
    const int b = it / 68, rr = it % 68, blk = rr >> 1, g = rr & 1;
    const bool isctx = blk < 2;
    const int row0 = ssd_row0(b, blk);
    const int s0 = isctx ? NL + b * CTX : b * S, s1 = s0 + (isctx ? CTX : S);
    bf16_t* XT = (bf16_t*)lds;
    bf16_t* BT = XT + 256 * 136;
    float* dtraw = (float*)(BT + 64 * 136);
    float* wgt = dtraw + 128 * 16;
    bf16_t* CT = (bf16_t*)(wgt + 8 * 128);
    const bf16_t* P = (const bf16_t*)(p.ws + WS_P);
    __syncthreads();
    {
        const bf16_t* A = (const bf16_t*)(p.ws + WS_H) + (size_t)(row0 + wid * 16 + fr) * 1024 + fq * 8;
        const bf16_t* Bw = (const bf16_t*)(p.ws + WS_WIN) + ((size_t)l * NIN + 2048 + fr) * 1024 + fq * 8;
        f32x4 acc = (f32x4){0.f, 0.f, 0.f, 0.f};
#pragma unroll 8
        for (int k = 0; k < 32; ++k) {
            const bf16x8 av = *(const bf16x8*)(A + k * 32), bv = *(const bf16x8*)(Bw + k * 32);
            acc = __builtin_amdgcn_mfma_f32_16x16x32_bf16(av, bv, acc, 0, 0, 0);
        }
        float* DT = (float*)(p.ws + WS_DT + (size_t)l * DT_STRIDE);
#pragma unroll
        for (int j = 0; j < 4; ++j) {
            dtraw[(wid * 16 + fq * 4 + j) * 16 + fr] = acc[j];
            if (g == 0) DT[(size_t)(row0 + wid * 16 + fq * 4 + j) * 16 + fr] = acc[j];
        }
    }
    {
        bf16_t* UXT = (bf16_t*)(p.ws + WS_UXT) + (size_t)it * 256 * 128;
#pragma unroll 1
        for (int k = 0; k < 3; ++k) {
            const int u = tid + NTHR * k, cc = u % 384, tq = u / 384;
            const int col = cc < 256 ? g * 256 + cc : (cc < 320 ? 512 + g * 64 + (cc - 256) : 640 + g * 64 + (cc - 320));
            float cw[5];
#pragma unroll
            for (int w = 0; w < 5; ++w) cw[w] = p.in[I_CONVW][(l * 5 + w) * 768 + col];
            const float cb = p.in[I_CONVB][l * 768 + col];
            const unsigned* src = (const unsigned*)(P + OXBC + (col & ~1));
            const int csh = (col & 1) * 16;
            unsigned raw[36];
#pragma unroll
            for (int i = 0; i < 36; ++i) {
                const int rw = row0 + tq * 32 - 2 + i;
                raw[i] = (rw >= s0 && rw < s1) ? src[(size_t)rw * (NP / 2)] : 0u;
            }
            __builtin_amdgcn_sched_barrier(0);
            float v[36];
#pragma unroll
            for (int i = 0; i < 36; ++i) v[i] = __uint_as_float((raw[i] >> csh) << 16);
#pragma unroll
            for (int ch = 0; ch < 4; ++ch) {
                const int t0 = tq * 32 + ch * 8;
                float o[8];
#pragma unroll
                for (int i = 0; i < 8; ++i) { const int q = ch * 8 + i; o[i] = silu_f(cb + v[q] * cw[0] + v[q + 1] * cw[1] + v[q + 2] * cw[2] + v[q + 3] * cw[3] + v[q + 4] * cw[4]); }
                uint4 w; w.x = pack2bf(o[0], o[1]); w.y = pack2bf(o[2], o[3]); w.z = pack2bf(o[4], o[5]); w.w = pack2bf(o[6], o[7]);
                if (cc < 256) {
                    *(uint4*)(XT + cc * 136 + t0) = w;
                    *(uint4*)(UXT + (size_t)cc * 128 + t0) = w;
                } else if (cc < 320) {
                    *(uint4*)(BT + (cc - 256) * 136 + t0) = w;
                } else {
                    *(uint4*)(CT + (cc - 320) * 136 + t0) = w;
                }
            }
        }
    }
    __syncthreads();
    {
        bf16_t* UBN = (bf16_t*)(p.ws + WS_UBN) + (size_t)it * 128 * 64;
        bf16_t* UCN = (bf16_t*)(p.ws + WS_UCN) + (size_t)it * 128 * 64;
#pragma unroll
        for (int i = 0; i < 4; ++i) {
            const int id = wid * 4 + i, which = id >> 4, s = id & 15, c = lane >> 3, t = (8 * c + (lane & 7) + 8 * s) & 127;
            const bf16_t* sp = (which ? CT : BT) + (c * 8) * 136 + t;
            u32x4 w;
#pragma unroll
            for (int k = 0; k < 4; ++k) w[k] = (unsigned)sp[(2 * k) * 136] | ((unsigned)sp[(2 * k + 1) * 136] << 16);
            *(u32x4*)((which ? UCN : UBN) + (size_t)t * 64 + c * 8) = w;
        }
    }
    const int h = wid >> 1, d = wid & 1, hg = g * 4 + h;
    const size_t sidx = ((size_t)(b * 8 + hg) * 2 + d) * NBLK + blk;
    {
        const float a = -expf(p.in[I_ALOG][l * 16 + d * 8 + hg]);
        const float bias = p.in[I_DTB][l * 16 + d * 8 + hg];
        float cs0, cs1, dt0, dt1, total;
        ssd_cs(dtraw, d * 8 + hg, bias, a, d, lane, cs0, cs1, dt0, dt1, total);
        wgt[wid * 128 + 2 * lane] = expf(total - cs0) * dt0;
        wgt[wid * 128 + 2 * lane + 1] = expf(total - cs1) * dt1;
        if (lane == 0) st_wt((float*)(p.ws + WS_DEC + (size_t)l * DEC_STRIDE) + sidx, expf(total));
    }
    f32x4 acc[4][4];
#pragma unroll
    for (int pt = 0; pt < 4; ++pt)
#pragma unroll
        for (int nt = 0; nt < 4; ++nt) acc[pt][nt] = (f32x4){0.f, 0.f, 0.f, 0.f};
#pragma unroll 1
    for (int ks = 0; ks < 4; ++ks) {
        const float4 wa = *(const float4*)(wgt + wid * 128 + ks * 32 + fq * 8), wb = *(const float4*)(wgt + wid * 128 + ks * 32 + fq * 8 + 4);
        const float wv[8] = {wa.x, wa.y, wa.z, wa.w, wb.x, wb.y, wb.z, wb.w};
        bf16x8 bfr[4];
#pragma unroll
        for (int nt = 0; nt < 4; ++nt) bfr[nt] = *(const bf16x8*)(BT + (nt * 16 + fr) * 136 + ks * 32 + fq * 8);
#pragma unroll
        for (int pt = 0; pt < 4; ++pt) {
            const bf16x8 xa = *(const bf16x8*)(XT + (h * 64 + pt * 16 + fr) * 136 + ks * 32 + fq * 8);
            const bf16x8 xs = pack8bf(bf2f((unsigned short)xa[0]) * wv[0], bf2f((unsigned short)xa[1]) * wv[1], bf2f((unsigned short)xa[2]) * wv[2], bf2f((unsigned short)xa[3]) * wv[3],
                                      bf2f((unsigned short)xa[4]) * wv[4], bf2f((unsigned short)xa[5]) * wv[5], bf2f((unsigned short)xa[6]) * wv[6], bf2f((unsigned short)xa[7]) * wv[7]);
#pragma unroll
            for (int nt = 0; nt < 4; ++nt) acc[pt][nt] = __builtin_amdgcn_mfma_f32_16x16x32_bf16(xs, bfr[nt], acc[pt][nt], 0, 0, 0);
        }
    }
    float* ST = (float*)(p.ws + WS_ST) + sidx * 4096 + (fq * 4) * 64 + fr;
#pragma unroll
    for (int pt = 0; pt < 4; ++pt) {
#pragma unroll
        for (int nt = 0; nt < 4; ++nt)
#pragma unroll
            for (int j = 0; j < 4; ++j) ST[(pt * 16 + j) * 64 + nt * 16] = acc[pt][nt][j];
        __builtin_amdgcn_sched_barrier(0);
    }
}

__device__ __forceinline__ void ph_attn_ssd1(const Params& p, int l, unsigned char* lds, int mask = 3) {
    const int n_lat = NBATCH * 2 * (S / 64);
    const int n_ctx = (l == 0) ? NBATCH * 2 * (CTX / 64) : 0;
    const int first = (mask & 1) ? 0 : NITEM, lastx = (mask & 2) ? NITEM + n_lat + n_ctx : NITEM;
    for (int it = first + blockIdx.x; it < lastx; it += gridDim.x) {
        if (it < NITEM) {
            ssd1_item(p, l, lds, it);
        } else if (it < NITEM + n_lat) {
            const int i2 = it - NITEM, b = i2 / 128, r = i2 % 128, g = r / 64, t0 = (r % 64) * 64;
            attn_item(p, l, lds, b, g, t0, false);
        } else {
            const int i2 = it - NITEM - n_lat, b = i2 / 8, r = i2 % 8, g = r / 4, t0 = (r % 4) * 64;
            attn_item(p, l, lds, b, g, t0, true);
        }
    }
}

__device__ __forceinline__ void ph_ssd2(const Params& p, int l) {
    const float* ST = (const float*)(p.ws + WS_ST);
    const float* DEC = (const float*)(p.ws + WS_DEC + (size_t)l * DEC_STRIDE);
    bf16_t* HS = (bf16_t*)(p.ws + WS_HS);
    for (int idx = blockIdx.x * NTHR + threadIdx.x; idx < 128 * 1024; idx += gridDim.x * NTHR) {
        const int seq = idx >> 10, e4 = (idx & 1023) * 4, d = seq & 1;
        const float* stb = ST + (size_t)seq * NBLK * 4096 + e4;
        const float* dcb = DEC + (size_t)seq * NBLK;
        bf16_t* hsb = HS + (size_t)seq * NBLK * 4096 + e4;
        float4 hst = make_float4(0.f, 0.f, 0.f, 0.f);
#pragma unroll 1
        for (int half = 0; half < 2; ++half) {
            float4 sv[17]; float dc[17];
#pragma unroll
            for (int c = 0; c < 17; ++c) {
                const int cc = half * 17 + c;
                const int blk = d == 0 ? cc : (cc < 2 ? 1 - cc : 35 - cc);
                sv[c] = *(const float4*)(stb + (size_t)blk * 4096); dc[c] = dcb[blk];
            }
#pragma unroll
            for (int c = 0; c < 17; ++c) {
                const int cc = half * 17 + c;
                const int blk = d == 0 ? cc : (cc < 2 ? 1 - cc : 35 - cc);
                uint2 w; w.x = pack2bf(hst.x, hst.y); w.y = pack2bf(hst.z, hst.w);
                *(uint2*)(hsb + (size_t)blk * 4096) = w;
                hst.x = dc[c] * hst.x + sv[c].x; hst.y = dc[c] * hst.y + sv[c].y; hst.z = dc[c] * hst.z + sv[c].z; hst.w = dc[c] * hst.w + sv[c].w;
            }
        }
    }
}

__device__ __forceinline__ void ssd3_item(const Params& p, int l, unsigned char* lds, int it) {
    const int tid = threadIdx.x, wid = tid >> 6, lane = tid & 63, fr = lane & 15, fq = lane >> 4;
    const int b = it / 68, rr = it % 68, blk = rr >> 1, g = rr & 1;
    const int row0 = ssd_row0(b, blk);
    bf16_t* XT = (bf16_t*)lds;
    bf16_t* Cn = XT + 256 * 136;
    bf16_t* Bn = Cn + 128 * 72;
    bf16_t* Mst = Bn + 128 * 72;
    float* dtraw = (float*)Mst;
    float* csA = (float*)(Mst + 8 * 16 * 136);
    float* dtA = csA + 8 * 128;
    float* ssq = dtA + 8 * 128;
    __syncthreads();
    {
        const bf16_t* UXT = (const bf16_t*)(p.ws + WS_UXT) + (size_t)it * 256 * 128;
        const bf16_t* UBN = (const bf16_t*)(p.ws + WS_UBN) + (size_t)it * 128 * 64;
        const bf16_t* UCN = (const bf16_t*)(p.ws + WS_UCN) + (size_t)it * 128 * 64;
#pragma unroll
        for (int k = 0; k < 8; ++k) { const int c = tid + NTHR * k, row = c >> 4, tc = c & 15; *(uint4*)(XT + row * 136 + tc * 8) = *(const uint4*)(UXT + (size_t)row * 128 + tc * 8); }
#pragma unroll
        for (int k = 0; k < 2; ++k) {
            const int c = tid + NTHR * k, row = c >> 3, nc = c & 7;
            *(uint4*)(Cn + row * 72 + nc * 8) = *(const uint4*)(UCN + (size_t)row * 64 + nc * 8);
            *(uint4*)(Bn + row * 72 + nc * 8) = *(const uint4*)(UBN + (size_t)row * 64 + nc * 8);
        }
        *(float4*)(dtraw + tid * 4) = *(const float4*)((const float*)(p.ws + WS_DT + (size_t)l * DT_STRIDE) + (size_t)row0 * 16 + tid * 4);
    }
    __syncthreads();
    {
        const int h = wid >> 1, d = wid & 1, hg = g * 4 + h;
        const float a = -expf(p.in[I_ALOG][l * 16 + d * 8 + hg]);
        const float bias = p.in[I_DTB][l * 16 + d * 8 + hg];
        float cs0, cs1, dt0, dt1, total;
        ssd_cs(dtraw, d * 8 + hg, bias, a, d, lane, cs0, cs1, dt0, dt1, total);
        csA[wid * 128 + 2 * lane] = cs0; csA[wid * 128 + 2 * lane + 1] = cs1;
        dtA[wid * 128 + 2 * lane] = dt0; dtA[wid * 128 + 2 * lane + 1] = dt1;
    }
    __syncthreads();
    const int h = wid >> 1, rh = wid & 1, hg = g * 4 + h;
    bf16_t* Mw = Mst + wid * 16 * 136;
    const float dsk = p.in[I_DSKIP][l * 8 + hg];
    const bf16_t* P = (const bf16_t*)(p.ws + WS_P);
    bf16_t* MIX = (bf16_t*)(p.ws + WS_MIX);
    const float* nw = p.in[I_SSMNW] + l * 512 + hg * 64;
#pragma unroll 1
    for (int st = 0; st < 4; ++st) {
        const int i0 = rh * 64 + st * 16;
        f32x4 y[4];
#pragma unroll
        for (int pt = 0; pt < 4; ++pt) y[pt] = (f32x4){0.f, 0.f, 0.f, 0.f};
        bf16x8 cf[2];
#pragma unroll
        for (int ks = 0; ks < 2; ++ks) cf[ks] = *(const bf16x8*)(Cn + (i0 + fr) * 72 + ks * 32 + fq * 8);
#pragma unroll 1
        for (int d = 0; d < 2; ++d) {
            const float* cs = csA + (h * 2 + d) * 128;
            const float* dtv = dtA + (h * 2 + d) * 128;
            const bf16_t* HS = (const bf16_t*)(p.ws + WS_HS) + (((size_t)(b * 8 + hg) * 2 + d) * NBLK + blk) * 4096;
            bf16x8 hf[4][2];
#pragma unroll
            for (int pt = 0; pt < 4; ++pt)
#pragma unroll
                for (int ks = 0; ks < 2; ++ks) hf[pt][ks] = *(const bf16x8*)(HS + (pt * 16 + fr) * 64 + ks * 32 + fq * 8);
            float csi[4];
#pragma unroll
            for (int r = 0; r < 4; ++r) csi[r] = cs[i0 + 4 * fq + r];
#pragma unroll 1
            for (int jt = 0; jt < 8; ++jt) {
                const bool need = d == 0 ? (jt * 16 <= i0 + 15) : (jt * 16 + 15 >= i0);
                f32x4 gacc = (f32x4){0.f, 0.f, 0.f, 0.f};
                const int j = jt * 16 + fr;
                if (need) {
#pragma unroll
                    for (int ks = 0; ks < 2; ++ks) {
                        const bf16x8 bfv = *(const bf16x8*)(Bn + (jt * 16 + fr) * 72 + ks * 32 + fq * 8);
                        gacc = __builtin_amdgcn_mfma_f32_16x16x32_bf16(cf[ks], bfv, gacc, 0, 0, 0);
                    }
                    const float csj = cs[j], dtj = dtv[j];
#pragma unroll
                    for (int r = 0; r < 4; ++r) {
                        const int i = i0 + 4 * fq + r;
                        const bool ok = d == 0 ? (j <= i) : (j >= i);
                        gacc[r] = ok ? gacc[r] * __expf(csi[r] - csj) * dtj : 0.f;
                    }
                }
#pragma unroll
                for (int r = 0; r < 4; ++r) Mw[(4 * fq + r) * 136 + j] = f2bf(gacc[r]);
            }
#pragma unroll 1
            for (int k4 = 0; k4 < 4; ++k4) {
                const bool need = d == 0 ? (k4 * 32 <= i0 + 15) : (k4 * 32 + 31 >= i0);
                if (need) {
                    const bf16x8 mf = *(const bf16x8*)(Mw + fr * 136 + k4 * 32 + fq * 8);
#pragma unroll
                    for (int pt = 0; pt < 4; ++pt) {
                        const bf16x8 xf = *(const bf16x8*)(XT + (h * 64 + pt * 16 + fr) * 136 + k4 * 32 + fq * 8);
                        y[pt] = __builtin_amdgcn_mfma_f32_16x16x32_bf16(mf, xf, y[pt], 0, 0, 0);
                    }
                }
            }
#pragma unroll
            for (int pt = 0; pt < 4; ++pt) {
                f32x4 a2 = (f32x4){0.f, 0.f, 0.f, 0.f};
#pragma unroll
                for (int ks = 0; ks < 2; ++ks) a2 = __builtin_amdgcn_mfma_f32_16x16x32_bf16(cf[ks], hf[pt][ks], a2, 0, 0, 0);
#pragma unroll
                for (int r = 0; r < 4; ++r) y[pt][r] += __expf(csi[r]) * a2[r];
            }
        }
        float sq[4] = {0.f, 0.f, 0.f, 0.f};
#pragma unroll
        for (int pt = 0; pt < 4; ++pt)
#pragma unroll
            for (int r = 0; r < 4; ++r) {
                const int i = i0 + 4 * fq + r, pch = pt * 16 + fr;
                const float xv = bf2f(XT[(h * 64 + pch) * 136 + i]);
                const float z = bf2f(P[(size_t)(row0 + i) * NP + OZ + hg * 64 + pch]);
                const float gv = (y[pt][r] + dsk * xv) * silu_f(z);
                y[pt][r] = gv; sq[r] += gv * gv;
            }
#pragma unroll
        for (int r = 0; r < 4; ++r) {
            float s = sq[r];
            s += __shfl_xor(s, 1); s += __shfl_xor(s, 2); s += __shfl_xor(s, 4); s += __shfl_xor(s, 8);
            if (fr == 0) ssq[(i0 + 4 * fq + r) * 4 + h] = s;
        }
        __syncthreads();
#pragma unroll
        for (int r = 0; r < 4; ++r) {
            const int i = i0 + 4 * fq + r;
            const float4 s4 = *(const float4*)(ssq + i * 4);
            const float rstd = rsqrtf((s4.x + s4.y + s4.z + s4.w) * (1.f / 256.f) + EPS);
#pragma unroll
            for (int pt = 0; pt < 4; ++pt) {
                const int pch = pt * 16 + fr;
                MIX[(size_t)(row0 + i) * 1024 + 512 + hg * 64 + pch] = f2bf(y[pt][r] * rstd * nw[pch]);
            }
        }
    }
}

__device__ __forceinline__ void ph_ssd3_prepout(const Params& p, int l, unsigned char* lds) {
    const int nitem = (l == 0) ? NITEM : NITEM;
    for (int it = blockIdx.x; it < nitem; it += gridDim.x) ssd3_item(p, l, lds, it);
    if (l == 0) convert_tail(p, lds, 1, NITEM);
    const int rfirst = nitem % (int)gridDim.x;
    if ((int)blockIdx.x < rfirst) return;
    const int tid = threadIdx.x, lane = tid & 63, gw = ((int)blockIdx.x - rfirst) * NWAVE + (tid >> 6), GW = ((int)gridDim.x - rfirst) * NWAVE;
    const float* ATT = (const float*)(p.ws + WS_ATT);
    bf16_t* MIX = (bf16_t*)(p.ws + WS_MIX);
    const int nrows = (l == 0) ? NT : NL;
    for (int row = gw; row < nrows; row += GW) {
        float4 av[2];
        float ss = 0.f;
#pragma unroll
        for (int j = 0; j < 2; ++j) {
            av[j] = *(const float4*)(ATT + (size_t)row * 512 + j * 256 + lane * 4);
            ss += av[j].x * av[j].x + av[j].y * av[j].y + av[j].z * av[j].z + av[j].w * av[j].w;
        }
        ss = wave_sum(ss);
        const float rstd = rsqrtf(ss * (1.f / 512.f) + EPS);
#pragma unroll
        for (int j = 0; j < 2; ++j) {
            const int k = j * 256 + lane * 4;
            const float4 w = *(const float4*)(p.in[I_ATTNW] + l * 512 + k);
            uint2 o; o.x = pack2bf(av[j].x * rstd * w.x, av[j].y * rstd * w.y); o.y = pack2bf(av[j].z * rstd * w.z, av[j].w * rstd * w.w);
            *(uint2*)(MIX + (size_t)row * 1024 + k) = o;
        }
    }
}

__device__ __forceinline__ void ph_outproj(const Params& p, int l, unsigned char* lds) {
    g8::DenseOrder S; S.init(p.ws + WS_MIX, p.ws + WS_WOUT + (size_t)l * 1024 * 1024 * 2, (l == 0) ? NT : NL, 1024);
    g8::EpiResid E{(float*)(p.ws + WS_XW), (const float*)(p.ws + WS_MOD) + (size_t)l * 9 * 6144 + 2048};
    g8::gemm_phase<false, false>((LAS unsigned char*)lds, S, E);
    if (l == 0) convert_tail(p, lds, 2, (NT / 256) * 4);
}

template <bool DRY>
__device__ __forceinline__ void ph_prep2(const Params& p, int l, unsigned char* lds) {
    const int tid = threadIdx.x, wid = tid >> 6, lane = tid & 63, fr = lane & 15, fq = lane >> 4;
    const float* XW = (const float*)(p.ws + WS_XW);
    unsigned char* H8 = p.ws + (DRY ? WS_MIX : WS_H);
    const float* MOD = (const float*)(p.ws + WS_MOD);
    const float* nw = p.in[I_NFFN] + l * 1024;
    const bf16_t* WH = (const bf16_t*)(p.ws + WS_WRT) + (size_t)l * 2 * 32 * 1024;
    const bf16_t* WL = WH + 32 * 1024;
    int* cnt = (int*)(p.ws + WS_CNT) + l * 32;
    int* list = (int*)(p.ws + WS_LIST + (size_t)l * LIST_STRIDE);
    int* route = (int*)(p.ws + WS_ROUTE + (size_t)l * RG_STRIDE);
    float* gate = (float*)(p.ws + WS_GATE + (size_t)l * RG_STRIDE);
    float* wl = (float*)lds + wid * 16 * 33;
    int* hist = (int*)((float*)lds + 8 * 16 * 33);
    int* basee = hist + 32;
    const int nitems = ((l == 0) ? NT : NL) / 128;
    for (int it = blockIdx.x; it < nitems; it += gridDim.x) {
        const int r0 = it * 128 + wid * 16, mr = mod_row(r0);
        const float* sh = MOD + (size_t)(l * 9 + mr) * 6144 + 3072;
        const float* sc = sh + 1024;
        if (tid < 32) hist[tid] = 0;
        f32x4 acc[2] = {(f32x4){0.f, 0.f, 0.f, 0.f}, (f32x4){0.f, 0.f, 0.f, 0.f}};
        const float* xrow = XW + (size_t)(r0 + fr) * 1024 + fq * 8;
        float ss = 0.f;
#pragma unroll 4
        for (int ks = 0; ks < 32; ++ks) {
            const int k = ks * 32 + fq * 8;
            const float4 x0 = *(const float4*)(xrow + ks * 32), x1 = *(const float4*)(xrow + ks * 32 + 4);
            const float4 w0 = *(const float4*)(nw + k), w1 = *(const float4*)(nw + k + 4), s0 = *(const float4*)(sc + k), s1 = *(const float4*)(sc + k + 4);
            ss += x0.x * x0.x + x0.y * x0.y + x0.z * x0.z + x0.w * x0.w + x1.x * x1.x + x1.y * x1.y + x1.z * x1.z + x1.w * x1.w;
            const float xa[8] = {x0.x * w0.x * (1.f + s0.x), x0.y * w0.y * (1.f + s0.y), x0.z * w0.z * (1.f + s0.z), x0.w * w0.w * (1.f + s0.w),
                                 x1.x * w1.x * (1.f + s1.x), x1.y * w1.y * (1.f + s1.y), x1.z * w1.z * (1.f + s1.z), x1.w * w1.w * (1.f + s1.w)};
            const bf16x8 ahi = pack8bf(xa[0], xa[1], xa[2], xa[3], xa[4], xa[5], xa[6], xa[7]);
            const bf16x8 alo = pack8bf(xa[0] - bf2f((unsigned short)ahi[0]), xa[1] - bf2f((unsigned short)ahi[1]), xa[2] - bf2f((unsigned short)ahi[2]), xa[3] - bf2f((unsigned short)ahi[3]),
                                       xa[4] - bf2f((unsigned short)ahi[4]), xa[5] - bf2f((unsigned short)ahi[5]), xa[6] - bf2f((unsigned short)ahi[6]), xa[7] - bf2f((unsigned short)ahi[7]));
#pragma unroll
            for (int nt = 0; nt < 2; ++nt) {
                const bf16x8 bh = *(const bf16x8*)(WH + (size_t)(nt * 16 + fr) * 1024 + k), bl = *(const bf16x8*)(WL + (size_t)(nt * 16 + fr) * 1024 + k);
                acc[nt] = __builtin_amdgcn_mfma_f32_16x16x32_bf16(ahi, bh, acc[nt], 0, 0, 0);
                acc[nt] = __builtin_amdgcn_mfma_f32_16x16x32_bf16(ahi, bl, acc[nt], 0, 0, 0);
                acc[nt] = __builtin_amdgcn_mfma_f32_16x16x32_bf16(alo, bh, acc[nt], 0, 0, 0);
            }
        }
        ss += __shfl_xor(ss, 16); ss += __shfl_xor(ss, 32);
        const float my_rstd = rsqrtf(ss * (1.f / 1024.f) + EPS);
#pragma unroll 4
        for (int rr = 0; rr < 16; ++rr) {
            const float* xr = XW + (size_t)(r0 + rr) * 1024;
            const float rstd = __shfl(my_rstd, rr);
#pragma unroll
            for (int j = 0; j < 4; ++j) {
                const int k = j * 256 + lane * 4;
                const float4 xv = *(const float4*)(xr + k);
                const float4 w = *(const float4*)(nw + k), a = *(const float4*)(sc + k), b4 = *(const float4*)(sh + k);
                const unsigned o = pack4fp8((xv.x * rstd * w.x * (1.f + a.x) + b4.x) * F8_ASCALE, (xv.y * rstd * w.y * (1.f + a.y) + b4.y) * F8_ASCALE,
                                            (xv.z * rstd * w.z * (1.f + a.z) + b4.z) * F8_ASCALE, (xv.w * rstd * w.w * (1.f + a.w) + b4.w) * F8_ASCALE);
                *(unsigned*)(H8 + (size_t)(r0 + rr) * 1024 + k) = o;
            }
        }
        {
            const float* c9 = (const float*)(p.ws + WS_C9) + (l * 9 + mr) * 32;
#pragma unroll
            for (int r = 0; r < 4; ++r) {
                const float rs = __shfl(my_rstd, 4 * fq + r);
#pragma unroll
                for (int nt = 0; nt < 2; ++nt) wl[(4 * fq + r) * 33 + nt * 16 + fr] = acc[nt][r] * rs + c9[nt * 16 + fr];
            }
        }
        const int rrow = lane >> 2, kk = lane & 3;
        float lg[32];
#pragma unroll
        for (int e2 = 0; e2 < 32; ++e2) lg[e2] = wl[rrow * 33 + e2];
        unsigned taken = 0u;
        float tv[4]; int ti[4];
#pragma unroll
        for (int k = 0; k < 4; ++k) {
            float best = -3.0e38f; int bi = 0;
#pragma unroll
            for (int e2 = 0; e2 < 32; ++e2) {
                const bool ok = !((taken >> e2) & 1u) && lg[e2] > best;
                best = ok ? lg[e2] : best; bi = ok ? e2 : bi;
            }
            taken |= 1u << bi; tv[k] = best; ti[k] = bi;
        }
        const float e1 = __expf(tv[1] - tv[0]), e2v = __expf(tv[2] - tv[0]), e3 = __expf(tv[3] - tv[0]);
        const float inv = 1.f / (1.f + e1 + e2v + e3);
        const int ek = kk == 0 ? ti[0] : kk == 1 ? ti[1] : kk == 2 ? ti[2] : ti[3];
        const float gk = (kk == 0 ? 1.f : kk == 1 ? e1 : kk == 2 ? e2v : e3) * inv;
        if (DRY) { asm volatile("" :: "v"(gk), "v"(ek)); continue; }
        __syncthreads();
        const int rank = atomicAdd(&hist[ek], 1);
        __syncthreads();
        if (tid < 32) { const int hc = hist[tid]; basee[tid] = hc ? atomicAdd(&cnt[tid], hc) : 0; }
        __syncthreads();
        const int slot = basee[ek] + rank, row = r0 + rrow;
        st_wt(list + (size_t)ek * NT + slot, row);
        route[row * 4 + kk] = (ek << 16) | slot;
        gate[row * 4 + kk] = gk;
        __syncthreads();
    }
    if (!DRY && l == 0) convert_tail(p, lds, 3, nitems);
}

__device__ __forceinline__ void ph_moe1(const Params& p, int l, unsigned char* lds) {
    g8::MoeOrder<true, 1024> S{(const int*)(p.ws + WS_CNT) + l * 32, (const int*)(p.ws + WS_LIST + (size_t)l * LIST_STRIDE), (const char*)(p.ws + WS_H),
                               (const char*)(p.ws + WS_WGU) + (size_t)l * 32 * 2048 * 1024, (int)gridDim.x, (int)blockIdx.x, nullptr};
    S.prepare((LAS int*)((LAS unsigned char*)lds + g8::MTAB_OFF));
    g8::EpiSwigluF8 E{p.ws + WS_ACT, p.in[I_BGU] + (size_t)l * 32 * 2048};
    g8::gemm_phase_f8<true, true>((LAS unsigned char*)lds, S, E);
}
__device__ __forceinline__ void ph_moe2(const Params& p, int l, unsigned char* lds) {
    g8::MoeOrder<false, 1024> S{(const int*)(p.ws + WS_CNT) + l * 32, (const int*)(p.ws + WS_LIST + (size_t)l * LIST_STRIDE), (const char*)(p.ws + WS_ACT),
                                (const char*)(p.ws + WS_WDN) + (size_t)l * 32 * 1024 * 1024, (int)gridDim.x, (int)blockIdx.x, nullptr};
    S.prepare((LAS int*)((LAS unsigned char*)lds + g8::MTAB_OFF));
    g8::EpiBiasBf16 E{p.ws + WS_Y, p.in[I_BDN] + (size_t)l * 32 * 1024};
    g8::gemm_phase_f8<false, true>((LAS unsigned char*)lds, S, E);
}

__device__ __forceinline__ void ph_final(const Params& p) {
    const int tid = threadIdx.x, lane = tid & 63, gw = blockIdx.x * NWAVE + (tid >> 6), GW = gridDim.x * NWAVE;
    const float* XW = (const float*)(p.ws + WS_XW);
    const float* MOD = (const float*)(p.ws + WS_MOD);
    const unsigned char* Y = p.ws + WS_Y;
    const int mybase = expert_rowbase((const int*)(p.ws + WS_CNT) + 32, lane & 31);
    for (int row = gw; row < NL; row += GW) {
        const int mr = mod_row(row);
        const int* route = (const int*)(p.ws + WS_ROUTE + RG_STRIDE) + row * 4;
        const float* gate = (const float*)(p.ws + WS_GATE + RG_STRIDE) + row * 4;
        const float* g2 = MOD + (size_t)(1 * 9 + mr) * 6144 + 5120;
        float4 xv[4], fs[4];
#pragma unroll
        for (int j = 0; j < 4; ++j) { xv[j] = *(const float4*)(XW + (size_t)row * 1024 + j * 256 + lane * 4); fs[j] = make_float4(0.f, 0.f, 0.f, 0.f); }
#pragma unroll
        for (int k = 0; k < 4; ++k) {
            const int rt = route[k]; const float gk = gate[k] * (1.f / F8_YSCALE);
            const int e = rt >> 16, slot = rt & 0xffff;
            const int pos = __shfl(mybase, e) + slot;
            const unsigned char* yr = Y + (size_t)pos * 1024;
#pragma unroll
            for (int j = 0; j < 4; ++j) {
                const unsigned w = *(const unsigned*)(yr + j * 256 + lane * 4);
                const auto lo2 = __builtin_amdgcn_cvt_pk_f32_fp8(w, false), hi2 = __builtin_amdgcn_cvt_pk_f32_fp8(w, true);
                fs[j].x += gk * lo2[0]; fs[j].y += gk * lo2[1]; fs[j].z += gk * hi2[0]; fs[j].w += gk * hi2[1];
            }
        }
        float ss = 0.f;
#pragma unroll
        for (int j = 0; j < 4; ++j) {
            const float4 g = *(const float4*)(g2 + j * 256 + lane * 4);
            xv[j].x += g.x * fs[j].x; xv[j].y += g.y * fs[j].y; xv[j].z += g.z * fs[j].z; xv[j].w += g.w * fs[j].w;
            ss += xv[j].x * xv[j].x + xv[j].y * xv[j].y + xv[j].z * xv[j].z + xv[j].w * xv[j].w;
        }
        ss = wave_sum(ss);
        const float rstd = rsqrtf(ss * (1.f / 1024.f) + EPS);
#pragma unroll
        for (int j = 0; j < 4; ++j) {
            const int k = j * 256 + lane * 4;
            const float4 w = *(const float4*)(p.in[I_FNW] + k);
            *(float4*)(p.out + (size_t)row * 1024 + k) = make_float4(xv[j].x * rstd * w.x, xv[j].y * rstd * w.y, xv[j].z * rstd * w.z, xv[j].w * rstd * w.w);
        }
    }
}

#define XB_TMO      128
#define XB_XCNT(j)  (256  + 64 * (j))
#define XB_XSUB(j)  (1280 + 64 * (j))
#define XB_XGEN(j)  (2304 + 64 * (j))
#define XB_TOP      3328
#define XB_TOPGEN   3392
#define XCD_BAR_WORDS 3456
#define XB_SPIN_CAP (1u << 18)
__device__ __forceinline__ unsigned xb_ld(unsigned* p)              { return __hip_atomic_load(p, __ATOMIC_RELAXED, __HIP_MEMORY_SCOPE_AGENT); }
__device__ __forceinline__ unsigned xb_add(unsigned* p, unsigned v) { return __hip_atomic_fetch_add(p, v, __ATOMIC_RELAXED, __HIP_MEMORY_SCOPE_AGENT); }
__device__ __forceinline__ unsigned xb_xcc_id() { return (unsigned)__builtin_amdgcn_s_getreg((3 << 11) | 20) & 0xFu; }
#define XB_SPIN(cond, bar) do { unsigned _sp = 0; while (cond) { __builtin_amdgcn_s_sleep(1); \
    if ((++_sp & 255u) == 0u) { if (xb_ld(&(bar)[XB_TMO])) break; if (_sp > XB_SPIN_CAP) { atomicAdd(&(bar)[XB_TMO], 1u); break; } } } } while (0)
struct XcdBarrier { unsigned* bar; unsigned x; volatile LAS unsigned* st; };
__device__ __forceinline__ XcdBarrier xcd_barrier_post(unsigned* bar, volatile LAS unsigned* st) {
    XcdBarrier b; b.bar = bar; b.x = xb_xcc_id(); b.st = st;
    if (threadIdx.x == 0) (void)xb_add(&bar[XB_XCNT(b.x)], 1u);
    return b;
}
__device__ __forceinline__ void xcd_barrier_complete(unsigned* bar, unsigned x, unsigned& nloc, unsigned& nx) {
    const unsigned G = gridDim.x * gridDim.y * gridDim.z;
    unsigned sum, cnt, mine, sp = 0u;
    for (;;) {
        sum = 0u; cnt = 0u; mine = 0u;
#pragma unroll
        for (unsigned j = 0; j < 16; ++j) { const unsigned c = xb_ld(&bar[XB_XCNT(j)]); sum += c; cnt += (c > 0u) ? 1u : 0u; mine = (j == x) ? c : mine; }
        if (sum == G) break;
        __builtin_amdgcn_s_sleep(1);
        if ((++sp & 255u) == 0u) { if (xb_ld(&bar[XB_TMO])) break; if (sp > XB_SPIN_CAP) { atomicAdd(&bar[XB_TMO], 1u); break; } }
    }
    nloc = mine > 0u ? mine : 1u; nx = cnt > 0u ? cnt : 1u;
}
__device__ __forceinline__ void xcd_barrier(const XcdBarrier& b) {
    asm volatile("s_waitcnt vmcnt(0)" ::: "memory");
    __syncthreads();
    if (threadIdx.x == 0) {
        unsigned* bar = b.bar;
        __builtin_amdgcn_s_waitcnt(0);
        unsigned nloc = b.st[0], nx = b.st[1];
        if (nloc == 0u) { xcd_barrier_complete(bar, b.x, nloc, nx); b.st[0] = nloc; b.st[1] = nx; }
        const unsigned old = xb_add(&bar[XB_XSUB(b.x)], 1u);
        const unsigned gen = old / nloc;
        if (old + 1u == (gen + 1u) * nloc) {
            __builtin_amdgcn_fence(__ATOMIC_RELEASE, "agent");
            asm volatile("s_waitcnt vmcnt(0)" ::: "memory");
            const unsigned og = xb_add(&bar[XB_TOP], 1u);
            const unsigned tg = og / nx;
            if (og + 1u == (tg + 1u) * nx) xb_add(&bar[XB_TOPGEN], 1u);
            else XB_SPIN(xb_ld(&bar[XB_TOPGEN]) == tg, bar);
            __builtin_amdgcn_fence(__ATOMIC_ACQUIRE, "agent");
            xb_add(&bar[XB_XGEN(b.x)], 1u);
            asm volatile("s_waitcnt vmcnt(0)" ::: "memory");
        } else {
            XB_SPIN(xb_ld(&bar[XB_XGEN(b.x)]) == gen, bar);
            __builtin_amdgcn_fence(__ATOMIC_ACQUIRE, "agent");
            asm volatile("s_waitcnt vmcnt(0)" ::: "memory");
        }
    }
    __syncthreads();
}

#ifndef PROBE_KIND
#define PROBE_KIND 0
#endif
namespace g8 {
struct EpiNone {
    __device__ __forceinline__ void operator()(const f32x4 (&acc)[2][2][4][2], const Unit&, int, int, int, int) const {
#pragma unroll
        for (int ai = 0; ai < 2; ++ai)
#pragma unroll
            for (int m = 0; m < 4; ++m) asm volatile("" :: "v"(acc[ai][0][m][0]), "v"(acc[ai][0][m][1]), "v"(acc[ai][1][m][0]), "v"(acc[ai][1][m][1]));
    }
};
}
__device__ __forceinline__ void ph_probe(const Params& p, unsigned char* lds, const XcdBarrier* xb) {
#if PROBE_KIND == 8
    for (int i = 0; i < 10; ++i) xcd_barrier(*xb);
#elif PROBE_KIND == 6
    ph_attn_ssd1(p, 0, lds, 2);
#elif PROBE_KIND == 7
    ph_attn_ssd1(p, 0, lds, 1);
#elif PROBE_KIND == 4
    ph_prep2<true>(p, 0, lds);
#elif PROBE_KIND == 5
    { g8::DenseOrder S; S.init(p.ws + WS_MIX, p.ws + WS_WOUT, NT, 1024); g8::EpiNone E; g8::gemm_phase<false, false>((LAS unsigned char*)lds, S, E); }
#endif
}

constexpr int N_PHASES = 20;
__global__ void __launch_bounds__(NTHR, 2) fwd(Params p) {
    extern __shared__ __attribute__((aligned(16))) unsigned char lds[];
    const int lo = p.ph_lo, hi = p.ph_hi;
    volatile LAS unsigned* xbst = (volatile LAS unsigned*)((LAS unsigned char*)lds + LDS_BYTES - 16);
    if (threadIdx.x < 4) xbst[threadIdx.x] = 0u;
    __syncthreads();
    const XcdBarrier xbar = xcd_barrier_post((unsigned*)(p.ws + WS_CTL), xbst);
#ifndef DUP_PHASE
#define DUP_PHASE -1
#endif
    if (lo == 0x7fffffff) cg::this_grid().sync();
#define PH(k, call) if (lo <= (k) && (k) < hi) { if ((k) > lo) xcd_barrier(xbar); call; if ((k) == DUP_PHASE) { call; } if (PROBE_KIND != 0 && (k) == (PROBE_KIND >= 6 ? 3 : 7)) { xcd_barrier(xbar); ph_probe(p, lds, &xbar); } }
    PH(0, ph_setup(p, lds))
    PH(1, ph_prep1(p, 0))
    PH(2, ph_inproj(p, 0, lds))
    PH(3, ph_attn_ssd1(p, 0, lds))
    PH(4, ph_ssd2(p, 0))
    PH(5, ph_ssd3_prepout(p, 0, lds))
    PH(6, ph_outproj(p, 0, lds))
    PH(7, ph_prep2<false>(p, 0, lds))
    PH(8, ph_moe1(p, 0, lds))
    PH(9, ph_moe2(p, 0, lds))
    PH(10, ph_prep1(p, 1))
    PH(11, ph_inproj(p, 1, lds))
    PH(12, ph_attn_ssd1(p, 1, lds))
    PH(13, ph_ssd2(p, 1))
    PH(14, ph_ssd3_prepout(p, 1, lds))
    PH(15, ph_outproj(p, 1, lds))
    PH(16, ph_prep2<false>(p, 1, lds))
    PH(17, ph_moe1(p, 1, lds))
    PH(18, ph_moe2(p, 1, lds))
    PH(19, ph_final(p))
#undef PH
}

extern "C" void kernel_launch(void* const* d_in, const int* in_sizes, int n_in, void* d_out, int out_size, void* d_ws, size_t ws_size, hipStream_t stream) {
    static int grid = 0;
    if (grid == 0) {
        if (n_in != 25 || ws_size < WS_END) { fprintf(stderr, "kernel_launch: unexpected n_in %d or ws_size %zu < %zu\n", n_in, ws_size, (size_t)WS_END); grid = -1; return; }
        int dev = 0, cus = 0, per_cu = 0;
        hipGetDevice(&dev);
        hipDeviceGetAttribute(&cus, hipDeviceAttributeMultiprocessorCount, dev);
        hipFuncSetAttribute((const void*)fwd, hipFuncAttributeMaxDynamicSharedMemorySize, LDS_BYTES);
        hipOccupancyMaxActiveBlocksPerMultiprocessor(&per_cu, (const void*)fwd, NTHR, LDS_BYTES);
        if (per_cu < 1) per_cu = 1;
        if (per_cu > 1) per_cu = 1;
        grid = cus * per_cu;
        fprintf(stderr, "kernel_launch: grid %d (%d per CU), ws need %zu have %zu\n", grid, per_cu, (size_t)WS_END, ws_size);
    }
    if (grid < 0) return;
    Params p{};
    for (int i = 0; i < 25; ++i) p.in[i] = (const float*)d_in[i];
    p.out = (float*)d_out; p.ws = (unsigned char*)d_ws;
    (void)hipMemsetAsync((unsigned char*)d_ws + WS_CTL, 0, XCD_BAR_WORDS * 4, stream);
#if N_LAUNCH_MODE == 0
    for (int ph = 0; ph < N_PHASES; ++ph) {
        p.ph_lo = ph; p.ph_hi = ph + 1;
        hipLaunchKernelGGL(fwd, dim3(grid), dim3(NTHR), LDS_BYTES, stream, p);
    }
#else
    p.ph_lo = 0; p.ph_hi = N_PHASES;
    void* args[] = {&p};
    hipError_t e = hipLaunchCooperativeKernel((const void*)fwd, dim3(grid), dim3(NTHR), args, LDS_BYTES, stream);
    if (e != hipSuccess) fprintf(stderr, "cooperative launch failed: %s (grid %d)\n", hipGetErrorString(e), grid);
#endif
}
```
